# Optimizing an MI355X kernel written in HIP

```python
import math
import jax, jax.numpy as jnp
from jax import lax
import numpy as np

D_MODEL = 1024
BATCH = 2
SEQ = 16384
DEPTH = 2

D_MIX = D_MODEL
D_A = D_MIX // 4
H_A = 4
HD_A = D_A // H_A
CHUNK = 128
D_B = D_MIX // 2
H_B = 4
DH_B = D_B // (2 * H_B)
D_C = D_MIX // 4
G_C = 4
GD_C = D_C // G_C
POOL_WINDOWS = (2, 4, 8, 16)
D_IN = 2 * D_A + 3 * D_B + D_C
Q_BLOCK = 128
NUM_BUCKETS = 32
MAX_EXACT = NUM_BUCKETS // 2
MAX_DISTANCE = 128
D_FF = 2816
N_EXPERTS = 8
TOP_K = 2
D_FF_EXPERT = 3584
N_DENSE = (DEPTH + 1) // 2
N_MOE = DEPTH // 2
ALPHA = (2 * DEPTH) ** 0.25
BETA = (8 * DEPTH) ** -0.25
EPS = 1e-5

kernel_name = "hybrid_gmlp_diffattn_pool_moe_deepnorm"

F32 = jnp.float32


def layer_norm(x, g, b):
    xf = x.astype(F32)
    mu = jnp.mean(xf, axis=-1, keepdims=True)
    var = jnp.mean(jnp.square(xf - mu), axis=-1, keepdims=True)
    return ((xf - mu) * lax.rsqrt(var + EPS) * g.astype(F32) + b.astype(F32)).astype(x.dtype)


def rms_norm(x, g):
    xf = x.astype(F32)
    ms = jnp.mean(jnp.square(xf), axis=-1, keepdims=True)
    return (xf * lax.rsqrt(ms + EPS) * g.astype(F32)).astype(x.dtype)


def t5_bucket(dist):
    n = jnp.maximum(dist, 0)
    nf = jnp.maximum(n, 1).astype(F32)
    large = MAX_EXACT + (jnp.log(nf / MAX_EXACT) / math.log(MAX_DISTANCE / MAX_EXACT)
                         * (NUM_BUCKETS - MAX_EXACT)).astype(jnp.int32)
    large = jnp.minimum(large, NUM_BUCKETS - 1)
    return jnp.where(n < MAX_EXACT, n, large)


def gmlp_mixer(z, ws, bs):
    bn, s, _ = z.shape
    z = jax.nn.gelu(z, approximate=False)
    u, v = jnp.split(z, 2, axis=-1)
    v = v.reshape(bn, s // CHUNK, CHUNK, H_A, HD_A)
    vf = v.astype(F32)
    mu = jnp.mean(vf, axis=-1, keepdims=True)
    var = jnp.mean(jnp.square(vf - mu), axis=-1, keepdims=True)
    vn = ((vf - mu) * lax.rsqrt(var + EPS)).astype(z.dtype)
    mask = jnp.tril(jnp.ones((CHUNK, CHUNK), dtype=bool))
    w = jnp.where(mask[None], ws, jnp.zeros_like(ws))
    sg = jnp.einsum('hts,bcshd->bcthd', w, vn) + bs.T[None, None, :, :, None]
    return u * sg.reshape(bn, s, D_A)


def diff_attention(q, k, v, rel_bias, lam, subln_g, lam_init):
    bn, s, _ = q.shape
    q = q.reshape(bn, s, H_B, 2, DH_B).transpose(0, 2, 3, 1, 4)
    k = k.reshape(bn, s, H_B, 2, DH_B).transpose(0, 2, 3, 1, 4)
    v = v.reshape(bn, s, H_B, 2 * DH_B).transpose(0, 2, 1, 3)
    nb = s // Q_BLOCK
    qb = q.reshape(bn, H_B, 2, nb, Q_BLOCK, DH_B).transpose(3, 0, 1, 2, 4, 5)
    kpos = jnp.arange(s)
    scale = DH_B ** -0.5

    def block(args):
        i, qblk = args
        qpos = i * Q_BLOCK + jnp.arange(Q_BLOCK)
        dist = qpos[:, None] - kpos[None, :]
        bias = jnp.transpose(rel_bias[t5_bucket(dist)].astype(F32), (2, 0, 1))
        logits = jnp.einsum('bhmqd,bhmkd->bhmqk', qblk, k).astype(F32) * scale
        logits = logits + bias[None, :, None]
        logits = jnp.where(dist >= 0, logits, -jnp.inf)
        p = jax.nn.softmax(logits, axis=-1)
        a = p[:, :, 0] - lam * p[:, :, 1]
        return jnp.einsum('bhqk,bhkv->bhqv', a.astype(v.dtype), v)

    o = lax.map(block, (jnp.arange(nb), qb))
    o = o.transpose(1, 2, 0, 3, 4).reshape(bn, H_B, s, 2 * DH_B)
    o = rms_norm(o, subln_g) * (1.0 - lam_init)
    return o.transpose(0, 2, 1, 3).reshape(bn, s, D_B)


def pool_mixer(c, w_pool, pool_scale):
    bn, s, _ = c.shape
    cf = c.astype(F32).reshape(bn, s, G_C, GD_C)
    cs = jnp.concatenate([jnp.zeros((bn, 1, G_C, GD_C), F32), jnp.cumsum(cf, axis=1)], axis=1)
    t = jnp.arange(s)[:, None]
    win = jnp.array(POOL_WINDOWS, dtype=jnp.int32)[None, :]
    start = jnp.maximum(t + 1 - win, 0)
    count = (t + 1 - start).astype(F32)
    gidx = jnp.arange(G_C)[None, :]
    window_sum = cs[:, 1:] - cs[:, start, gidx]
    y = (window_sum / count[None, :, :, None] - cf).astype(c.dtype)
    y = jnp.einsum('bsgc,gcd->bsgd', y, w_pool).reshape(bn, s, D_C)
    return y * pool_scale


def swiglu(x, w1, w3, w2):
    return (jax.nn.silu(x @ w1) * (x @ w3)) @ w2


def moe_ffn(x, router_w, w1, w3, w2):
    bn, s, d = x.shape
    xt = x.reshape(bn * s, d)
    logits = (xt @ router_w).astype(F32)
    top_v, top_i = lax.top_k(logits, TOP_K)
    top_w = jax.nn.softmax(top_v, axis=-1)
    gates = jnp.sum(jax.nn.one_hot(top_i, N_EXPERTS, dtype=F32) * top_w[..., None], axis=1)
    y = jnp.zeros_like(xt)
    for e in range(N_EXPERTS):
        y = y + gates[:, e:e + 1].astype(x.dtype) * swiglu(xt, w1[e], w3[e], w2[e])
    return y.reshape(bn, s, d)


def setup_inputs(seed: int = 0) -> dict:
    key = jax.random.key(seed)
    ks = jax.random.split(key, 24)
    nrm = lambda k, shape, sc: jax.random.normal(k, shape, F32) * sc
    return {
        "x": nrm(ks[0], (BATCH, SEQ, D_MODEL), 1.0),
        "w_in": nrm(ks[1], (DEPTH, D_MODEL, D_IN), D_MODEL ** -0.5),
        "w_out": nrm(ks[2], (DEPTH, D_MIX, D_MODEL), BETA * D_MIX ** -0.5),
        "gmlp_ws": nrm(ks[3], (DEPTH, H_A, CHUNK, CHUNK), CHUNK ** -0.5),
        "gmlp_bs": 1.0 + nrm(ks[4], (DEPTH, H_A, CHUNK), 0.02),
        "lam_q1": nrm(ks[5], (DEPTH, DH_B), 0.1),
        "lam_k1": nrm(ks[6], (DEPTH, DH_B), 0.1),
        "lam_q2": nrm(ks[7], (DEPTH, DH_B), 0.1),
        "lam_k2": nrm(ks[8], (DEPTH, DH_B), 0.1),
        "diff_subln_g": 1.0 + nrm(ks[9], (DEPTH, 2 * DH_B), 0.02),
        "rel_bias": nrm(ks[10], (NUM_BUCKETS, H_B), 0.5),
        "pool_w": nrm(ks[11], (DEPTH, G_C, GD_C, GD_C), GD_C ** -0.5),
        "pool_scale": 1.0 + nrm(ks[12], (DEPTH, D_C), 0.1),
        "ln1_g": 1.0 + nrm(ks[13], (DEPTH, D_MODEL), 0.02),
        "ln1_b": nrm(ks[14], (DEPTH, D_MODEL), 0.02),
        "ln2_g": 1.0 + nrm(ks[15], (DEPTH, D_MODEL), 0.02),
        "ln2_b": nrm(ks[16], (DEPTH, D_MODEL), 0.02),
        "ffn_w1": nrm(ks[17], (N_DENSE, D_MODEL, D_FF), D_MODEL ** -0.5),
        "ffn_w3": nrm(ks[18], (N_DENSE, D_MODEL, D_FF), D_MODEL ** -0.5),
        "ffn_w2": nrm(ks[19], (N_DENSE, D_FF, D_MODEL), BETA * D_FF ** -0.5),
        "router_w": nrm(ks[20], (N_MOE, D_MODEL, N_EXPERTS), D_MODEL ** -0.5),
        "moe_w1": nrm(ks[21], (N_MOE, N_EXPERTS, D_MODEL, D_FF_EXPERT), D_MODEL ** -0.5),
        "moe_w3": nrm(ks[22], (N_MOE, N_EXPERTS, D_MODEL, D_FF_EXPERT), D_MODEL ** -0.5),
        "moe_w2": nrm(ks[23], (N_MOE, N_EXPERTS, D_FF_EXPERT, D_MODEL), BETA * D_FF_EXPERT ** -0.5),
    }


def reference(x, w_in, w_out, gmlp_ws, gmlp_bs, lam_q1, lam_k1, lam_q2, lam_k2,
              diff_subln_g, rel_bias, pool_w, pool_scale, ln1_g, ln1_b, ln2_g, ln2_b,
              ffn_w1, ffn_w3, ffn_w2, router_w, moe_w1, moe_w3, moe_w2):
    o_a = 2 * D_A
    o_q = o_a + D_B
    o_k = o_q + D_B
    o_v = o_k + D_B
    for l in range(DEPTH):
        p = x @ w_in[l]
        lam_init = 0.8 - 0.6 * math.exp(-0.3 * l)
        lam = (jnp.exp(jnp.sum(lam_q1[l].astype(F32) * lam_k1[l].astype(F32)))
               - jnp.exp(jnp.sum(lam_q2[l].astype(F32) * lam_k2[l].astype(F32))) + lam_init)
        y_a = gmlp_mixer(p[..., :o_a], gmlp_ws[l], gmlp_bs[l])
        y_b = diff_attention(p[..., o_a:o_q], p[..., o_q:o_k], p[..., o_k:o_v],
                             rel_bias, lam, diff_subln_g[l], lam_init)
        y_c = pool_mixer(p[..., o_v:], pool_w[l], pool_scale[l])
        h = jnp.concatenate([y_a, y_b, y_c], axis=-1) @ w_out[l]
        x = layer_norm(ALPHA * x + h, ln1_g[l], ln1_b[l])
        if l % 2 == 0:
            i = l // 2
            f = swiglu(x, ffn_w1[i], ffn_w3[i], ffn_w2[i])
        else:
            i = l // 2
            f = moe_ffn(x, router_w[i], moe_w1[i], moe_w3[i], moe_w2[i])
        x = layer_norm(ALPHA * x + f, ln2_g[l], ln2_b[l])
    return x
```

```cpp
#include <hip/hip_runtime.h>
#include <cstdio>
#include <cstdint>

#define GAS __attribute__((address_space(1)))
#define LAS __attribute__((address_space(3)))
typedef unsigned short bf16;
typedef unsigned u32x4 __attribute__((ext_vector_type(4)));
typedef unsigned u32x2 __attribute__((ext_vector_type(2)));
typedef float f32x4 __attribute__((ext_vector_type(4)));
typedef float f32x2 __attribute__((ext_vector_type(2)));
typedef GAS unsigned gu32;

constexpr int BATCH = 2, SEQ = 16384, DM = 1024, M = BATCH * SEQ, DIN = 2304, DFF = 2816, NEXP = 8, DFE = 3584, DEPTH = 2;
constexpr float LN_EPS = 1e-5f;
constexpr float ALPHA = 1.4142135623730951f;
constexpr float LOG2E = 1.4426950408889634f;
constexpr float C2 = 0.125f * LOG2E;
constexpr int NWAVES = 8, NTHR = 512, GRID = 256;
constexpr int PP = DIN;
constexpr int PC_U = 0, PC_V = 256, PC_Q = 512, PC_K = 1024, PC_VA = 1536, PC_C = 2048;

constexpr size_t MiB = 1u << 20;
constexpr size_t WS_CTL = 0, CTL_ZERO_BYTES = 1 * MiB;
constexpr size_t WS_WB = 1 * MiB;
constexpr size_t WS_PWT = 1 * MiB + 256 * 1024;
constexpr size_t WS_ROUTE = 2 * MiB;
constexpr size_t WS_WIN = 4 * MiB;
constexpr size_t WS_WOUT = 13 * MiB;
constexpr size_t WS_W13 = 17 * MiB;
constexpr size_t WS_W2 = 28 * MiB;
constexpr size_t WS_MW13 = 34 * MiB;
constexpr size_t WS_MW2 = 146 * MiB;
constexpr size_t WS_XB = 202 * MiB;
constexpr size_t WS_BIG = 266 * MiB;
constexpr size_t WS_P = WS_BIG;
constexpr size_t WS_OSCR = WS_BIG + 144 * MiB;
constexpr size_t WS_HID = WS_BIG + 144 * MiB;
constexpr size_t WS_ASORT = WS_BIG;
constexpr size_t WS_HCH = WS_BIG + 132 * MiB;
constexpr size_t WS_XB8 = 96 * MiB;
constexpr size_t WS_ROWTOK = 510 * MiB;
constexpr size_t WS_END = 520 * MiB;
constexpr int CHUNK_TILES = 64;
constexpr int MAX_RT = 264;

constexpr int CW_BAR = 4096;
constexpr int CW_CUR = 16384;
constexpr int CW_XCC = 49152;
constexpr int CW_PAIR = 32768;

constexpr int RING_BYTES = 131072;
constexpr int LDSCTL_OFF = RING_BYTES, MISC_OFF = LDSCTL_OFF + 320;
constexpr int LDS_BYTES = 147456;

__device__ __forceinline__ unsigned f2bf(float f) { unsigned u = __builtin_bit_cast(unsigned, f); return (u + 0x7fffu + ((u >> 16) & 1u)) >> 16; }
__device__ __forceinline__ unsigned pk2(float lo, float hi) { return f2bf(lo) | (f2bf(hi) << 16); }
__device__ __forceinline__ float bflo(unsigned w) { return __builtin_bit_cast(float, w << 16); }
__device__ __forceinline__ float bfhi(unsigned w) { return __builtin_bit_cast(float, w & 0xffff0000u); }
__device__ __forceinline__ u32x2 pack4(f32x4 v) { u32x2 r; r.x = pk2(v.x, v.y); r.y = pk2(v.z, v.w); return r; }
__device__ __forceinline__ size_t opaque0() { unsigned z = 0u; asm volatile("" : "+s"(z)); return (size_t)z; }
__device__ __forceinline__ int opaque_tid() { int t = threadIdx.x; asm volatile("" : "+v"(t)); return t; }
__device__ __forceinline__ int opaque_s(int x) { asm volatile("" : "+s"(x)); return x; }
#define opq(p) ((p) + opaque0())
__device__ __forceinline__ float shx(float v, int lane, int o) { return __builtin_bit_cast(float, __builtin_amdgcn_ds_bpermute((lane ^ o) << 2, __builtin_bit_cast(int, v))); }
__device__ __forceinline__ float wave_sum(float v, int lane) {
#pragma unroll
    for (int o = 1; o < 64; o <<= 1) v += __builtin_bit_cast(float, __builtin_amdgcn_ds_bpermute((lane ^ o) << 2, __builtin_bit_cast(int, v)));
    return v;
}
__device__ __forceinline__ float gelu1(float v) {
    const float av = __builtin_fabsf(v), d = av * 0.2316418882f + 1.0f;
    const float t = __builtin_amdgcn_rcpf(d);
    float q = t * 0.5307027145f + (-0.7265760135f); q = q * t + 0.7107068705f; q = q * t + (-0.142248368f); q = q * t + 0.127414796f; q = q * t;
    const float s = (v * v) * (-0.72134752044f);
    const float e = __builtin_amdgcn_exp2f(s);
    const float m = v * (q * e), r = v - m;
    return v < 0.f ? m : r;
}
__device__ __forceinline__ f32x4 gelu4(f32x4 v) { f32x4 o; o.x = gelu1(v.x); o.y = gelu1(v.y); o.z = gelu1(v.z); o.w = gelu1(v.w); return o; }
__device__ __forceinline__ float silu1(float a) { return a * __builtin_amdgcn_rcpf(1.0f + __builtin_amdgcn_exp2f(-a * LOG2E)); }

#define XB_TMO      128
#define XB_XCNT(j)  (256  + 64 * (j))
#define XB_XSUB(j)  (1280 + 64 * (j))
#define XB_XGEN(j)  (2304 + 64 * (j))
#define XB_TOP      3328
#define XB_TOPGEN   3392
#define XCD_BAR_WORDS 3456
#define XB_SPIN_CAP (1u << 22)

__device__ __forceinline__ unsigned xb_ld(unsigned* p)              { return __hip_atomic_load(p, __ATOMIC_RELAXED, __HIP_MEMORY_SCOPE_AGENT); }
__device__ __forceinline__ unsigned xb_add(unsigned* p, unsigned v) { return __hip_atomic_fetch_add(p, v, __ATOMIC_RELAXED, __HIP_MEMORY_SCOPE_AGENT); }
__device__ __forceinline__ unsigned xb_xcc_id() { return (unsigned)__builtin_amdgcn_s_getreg((3 << 11) | 20) & 0xFu; }
#define XB_SPIN(cond, bar) do { unsigned _sp = 0; while (cond) { __builtin_amdgcn_s_sleep(1); \
    if ((++_sp & 255u) == 0u) { if (xb_ld(&(bar)[XB_TMO])) break; if (_sp > XB_SPIN_CAP) { atomicAdd(&(bar)[XB_TMO], 1u); break; } } } } while (0)

struct XcdBarrier { unsigned* bar; unsigned x; volatile LAS unsigned* st; };

__device__ __forceinline__ XcdBarrier xcd_barrier_post(unsigned* bar, volatile LAS unsigned* st) {
    XcdBarrier b; b.bar = bar; b.x = xb_xcc_id(); b.st = st;
    if (threadIdx.x == 0) (void)xb_add(&bar[XB_XCNT(b.x)], 1u);
    return b;
}
__device__ __forceinline__ void xcd_barrier_complete(unsigned* bar, unsigned x, unsigned& nloc, unsigned& nx) {
    const unsigned G = gridDim.x * gridDim.y * gridDim.z;
    unsigned sum, cnt, mine, sp = 0u;
    for (;;) {
        sum = 0u; cnt = 0u; mine = 0u;
#pragma unroll
        for (unsigned j = 0; j < 16; ++j) { const unsigned c = xb_ld(&bar[XB_XCNT(j)]); sum += c; cnt += (c > 0u) ? 1u : 0u; mine = (j == x) ? c : mine; }
        if (sum == G) break;
        __builtin_amdgcn_s_sleep(1);
        if ((++sp & 255u) == 0u) { if (xb_ld(&bar[XB_TMO])) break; if (sp > XB_SPIN_CAP) { atomicAdd(&bar[XB_TMO], 1u); break; } }
    }
    nloc = mine > 0u ? mine : 1u; nx = cnt > 0u ? cnt : 1u;
}
__device__ __forceinline__ void xcd_barrier(const XcdBarrier& b) {
    asm volatile("s_waitcnt vmcnt(0)" ::: "memory");
    __syncthreads();
    if (threadIdx.x == 0) {
        unsigned* bar = b.bar + opaque0();
        __builtin_amdgcn_s_waitcnt(0);
        unsigned nloc = b.st[0], nx = b.st[1];
        if (nloc == 0u) { xcd_barrier_complete(bar, b.x, nloc, nx); b.st[0] = nloc; b.st[1] = nx; }
        const unsigned old = xb_add(&bar[XB_XSUB(b.x)], 1u);
        const unsigned gen = old / nloc;
        if (old + 1u == (gen + 1u) * nloc) {
            __builtin_amdgcn_fence(__ATOMIC_RELEASE, "agent");
            asm volatile("s_waitcnt vmcnt(0)" ::: "memory");
            const unsigned og = xb_add(&bar[XB_TOP], 1u);
            const unsigned tg = og / nx;
            if (og + 1u == (tg + 1u) * nx) xb_add(&bar[XB_TOPGEN], 1u);
            else XB_SPIN(xb_ld(&bar[XB_TOPGEN]) == tg, bar);
            __builtin_amdgcn_fence(__ATOMIC_ACQUIRE, "agent");
            xb_add(&bar[XB_XGEN(b.x)], 1u);
            asm volatile("s_waitcnt vmcnt(0)" ::: "memory");
        } else {
            XB_SPIN(xb_ld(&bar[XB_XGEN(b.x)]) == gen, bar);
            __builtin_amdgcn_fence(__ATOMIC_ACQUIRE, "agent");
            asm volatile("s_waitcnt vmcnt(0)" ::: "memory");
        }
    }
    __syncthreads();
}

__device__ __forceinline__ void pair_sync(unsigned* w, const XcdBarrier& b, unsigned n = 2u) {
    asm volatile("s_waitcnt vmcnt(0)" ::: "memory");
    __syncthreads();
    if (threadIdx.x == 0) {
        unsigned* bar = b.bar + opaque0();
        bool same = true;
        for (unsigned j = 1; j < n; ++j) same = same && ((unsigned)__builtin_amdgcn_readfirstlane((int)xb_ld(bar - CW_BAR + CW_XCC + (blockIdx.x ^ (8u * j)))) == b.x + 1u);
        if (!same) { __builtin_amdgcn_fence(__ATOMIC_RELEASE, "agent"); asm volatile("s_waitcnt vmcnt(0)" ::: "memory"); }
        (void)xb_add(w, 1u);
        XB_SPIN(xb_ld(w) < n, bar);
        __builtin_amdgcn_fence(__ATOMIC_ACQUIRE, "agent");
        asm volatile("s_waitcnt vmcnt(0)" ::: "memory");
    }
    __syncthreads();
}
__device__ __forceinline__ int pair_panel(int c) { return (c & 7) * 16 + (c >> 4); }
__device__ __forceinline__ int pair_row0(int c) { return pair_panel(c) * 256 + ((c >> 3) & 1) * 128; }

struct Unit { int pm, pn, om, on, ge, gl; };
struct Gemm { const bf16* A; const bf16* Bt; int lda, K; int sa = 0, sb = 0; };

constexpr int NXCD = 8, WGM = 8;
struct StaticOrder {
    int nM, nN, nwg, G, c;
    __device__ __forceinline__ void init(int M_, int N_, int G_, int c_) { nM = M_ / 256; nN = N_ / 256; nwg = nM * nN; G = G_; c = c_; }
    __device__ __forceinline__ bool next(int i, Unit& u) const {
        long L = (long)i * G + c;
        {   const int full = nwg / G, part = nwg - full * G;
            if (i == full && part > 0) { if (c < G - part) return false; L = (long)i * G + (c - (G - part)); } }
        if (L >= nwg) return false;
        int wgid = (int)L; { const int q = nwg / NXCD, r = nwg % NXCD, xcd = wgid % NXCD, off = wgid / NXCD; wgid = (xcd < r ? xcd * (q + 1) : r * (q + 1) + (xcd - r) * q) + off; }
        const int nig = WGM * nN, gid = wgid / nig, fm = gid * WGM, gsz = (nM - fm) < WGM ? (nM - fm) : WGM;
        u.pm = fm + ((wgid % nig) % gsz); u.pn = (wgid % nig) / gsz; u.om = u.pm; u.on = u.pn; return true;
    }
    __device__ __forceinline__ void a_ready(const Unit&) const {}
    __device__ __forceinline__ void done(const Unit&) const {}
};
struct PairOrder {
    int c;
    __device__ __forceinline__ bool next(int i, Unit& u) const { if (i >= 2) return false; u.pm = pair_panel(c); u.pn = ((c >> 3) & 1) * 2 + i; u.om = u.pm; u.on = u.pn; return true; }
    __device__ __forceinline__ void a_ready(const Unit&) const {}
    __device__ __forceinline__ void done(const Unit&) const {}
};
struct QuadOrder {
    int c, nn;
    __device__ __forceinline__ bool next(int i, Unit& u) const { const int uu = i * 4 + ((c >> 3) & 3), hi = uu >= nn ? 1 : 0; if (uu >= 2 * nn) return false;
        int pn = uu - nn * hi;
        if (nn == 9 && pn < 4) pn = hi ? ((0x3102 >> (4 * pn)) & 3) : (pn ^ 2);
        u.pm = (c & 7) * 16 + (c >> 5) * 2 + hi; u.pn = pn; u.om = u.pm; u.on = u.pn; return true; }
    __device__ __forceinline__ void a_ready(const Unit&) const {}
    __device__ __forceinline__ void done(const Unit&) const {}
};
__device__ __forceinline__ int quad_id(int c) { return (c & 7) * 8 + (c >> 5); }
struct MoeOrder {
    int ts1, ts2, ts3, ts4, ts5, ts6, ts7;
    const int* rowtok;
    int c0, ntc, ncol, G, c, skipn; bool up;
    __device__ __forceinline__ bool next(int i, Unit& u) const {
        if (up && ntc == 128 && G == 256) {
            const int D = skipn, x = (D > 0) ? (3584 - (7 * (256 - D)) / 2 + 128) / 256 : 14, nx = 14 - x;
            int oc = c, oi = i;
            if (c < D) { if (i >= x) return false; }
            else if (i >= 14) { const int o = (c - D) + (i - 14) * (256 - D); if (nx == 0 || o >= D * nx) return false; oc = o / nx; oi = x + o % nx; }
            const int li = oc >> 3, rtl = (oc & 7) * 16 + (li >> 1), pn = (li & 1) * 14 + oi, rt = c0 + rtl;
            const int e = (rt >= ts1) + (rt >= ts2) + (rt >= ts3) + (rt >= ts4) + (rt >= ts5) + (rt >= ts6) + (rt >= ts7);
            int tse = 0; tse = (e == 1) ? ts1 : tse; tse = (e == 2) ? ts2 : tse; tse = (e == 3) ? ts3 : tse; tse = (e == 4) ? ts4 : tse; tse = (e == 5) ? ts5 : tse; tse = (e == 6) ? ts6 : tse; tse = (e == 7) ? ts7 : tse;
            u.pn = e * ncol + pn; u.on = pn; u.pm = rt; u.om = rtl; u.ge = e; u.gl = rt - tse; return true; }
        if (!up && ntc == 128 && G == 256) {
            if (i >= 2) return false;
            const int li = c >> 3, rtl = (c & 7) * 16 + (li >> 1), pn = (li & 1) * 2 + i, rt = c0 + rtl;
            const int e = (rt >= ts1) + (rt >= ts2) + (rt >= ts3) + (rt >= ts4) + (rt >= ts5) + (rt >= ts6) + (rt >= ts7);
            u.pn = e * ncol + pn; u.on = pn; u.pm = rtl; u.om = rt; return true; }
        long L = (long)i * G + c;
        if (skipn > 0) { const int act = G - skipn; L = (c < skipn) ? 3L * act + (long)i * G + c : ((i < 3) ? (long)i * act + (c - skipn) : 3L * act + (long)(i - 3) * G + c); }
        if (L >= (long)ntc * ncol) return false;
        const int rtl = (int)(L / ncol), pn = (int)(L % ncol), rt = c0 + rtl;
        const int e = (rt >= ts1) + (rt >= ts2) + (rt >= ts3) + (rt >= ts4) + (rt >= ts5) + (rt >= ts6) + (rt >= ts7);
        u.pn = e * ncol + pn; u.on = pn;
        if (up) { u.pm = rt; u.om = rtl; u.ge = e;
            int tse = 0; tse = (e == 1) ? ts1 : tse; tse = (e == 2) ? ts2 : tse; tse = (e == 3) ? ts3 : tse; tse = (e == 4) ? ts4 : tse; tse = (e == 5) ? ts5 : tse; tse = (e == 6) ? ts6 : tse; tse = (e == 7) ? ts7 : tse;
            u.gl = rt - tse; }
        else { u.pm = rtl; u.om = rt; }
        return true;
    }
    __device__ __forceinline__ void a_ready(const Unit&) const {}
    __device__ __forceinline__ void done(const Unit&) const {}
};

__device__ __forceinline__ u32x4 pack8(f32x4 a, f32x4 b) { u32x4 r; r.x = pk2(a.x, a.y); r.y = pk2(a.z, a.w); r.z = pk2(b.x, b.y); r.w = pk2(b.z, b.w); return r; }
struct EpiInProj { bf16* P; static constexpr bool PERM = true;
    __device__ __forceinline__ void emit8(int row, int on, int c, f32x4 lo0, f32x4 lo1, f32x4 hi0, f32x4 hi1) const {
        if (on < 2) { lo0 = gelu4(lo0); lo1 = gelu4(lo1); hi0 = gelu4(hi0); hi1 = gelu4(hi1); } else if (on < 4) { lo0 = lo0 * C2; lo1 = lo1 * C2; hi0 = hi0 * C2; hi1 = hi1 * C2; }
        bf16* rp = P + (size_t)row * PP + on * 256 + c;
        *(u32x4*)rp = pack8(lo0, lo1); *(u32x4*)(rp + 128) = pack8(hi0, hi1);
    }
    __device__ __forceinline__ void emit(int row, int on, int c, f32x4 lo, f32x4 hi) const {
        if (on < 2) { lo = gelu4(lo); hi = gelu4(hi); } else if (on < 4) { lo = lo * C2; hi = hi * C2; }
        bf16* rp = P + (size_t)row * PP + on * 256 + c;
        *(u32x2*)rp = pack4(lo); *(u32x2*)(rp + 128) = pack4(hi);
    } };
struct EpiResid { bf16* xb; static constexpr bool PERM = true;
    __device__ __forceinline__ void emit8(int row, int on, int c, f32x4 lo0, f32x4 lo1, f32x4 hi0, f32x4 hi1) const {
        bf16* rp = xb + (size_t)row * DM + on * 256 + c;
        const u32x4 a = *(const u32x4*)rp, b = *(const u32x4*)(rp + 128);
        const f32x4 a0 = {bflo(a.x), bfhi(a.x), bflo(a.y), bfhi(a.y)}, a1 = {bflo(a.z), bfhi(a.z), bflo(a.w), bfhi(a.w)};
        const f32x4 b0 = {bflo(b.x), bfhi(b.x), bflo(b.y), bfhi(b.y)}, b1 = {bflo(b.z), bfhi(b.z), bflo(b.w), bfhi(b.w)};
        *(u32x4*)rp = pack8(a0 * ALPHA + lo0, a1 * ALPHA + lo1); *(u32x4*)(rp + 128) = pack8(b0 * ALPHA + hi0, b1 * ALPHA + hi1);
    }
    __device__ __forceinline__ void emit(int, int, int, f32x4, f32x4) const {} };
struct EpiSwiglu { bf16* H; int ldh; static constexpr bool PERM = true;
    __device__ __forceinline__ void emit8(int row, int on, int c, f32x4 lo0, f32x4 lo1, f32x4 hi0, f32x4 hi1) const {
        f32x4 v0, v1; v0.x = silu1(lo0.x) * hi0.x; v0.y = silu1(lo0.y) * hi0.y; v0.z = silu1(lo0.z) * hi0.z; v0.w = silu1(lo0.w) * hi0.w;
        v1.x = silu1(lo1.x) * hi1.x; v1.y = silu1(lo1.y) * hi1.y; v1.z = silu1(lo1.z) * hi1.z; v1.w = silu1(lo1.w) * hi1.w;
        const int col = on * 128 + c;
        *(u32x4*)(H + (size_t)(row >> 1) * (2 * ldh) + (col >> 5) * 64 + (row & 1) * 32 + (col & 31)) = pack8(v0, v1);
    }
    __device__ __forceinline__ void emit(int, int, int, f32x4, f32x4) const {} };
constexpr float F8_SC_Y = 16.0f, F8_SC_H = 16.0f, F8_SC_W = 64.0f;
constexpr int F8_E8_Y = 0x7a7a7a7a, F8_E8_H = 0x7a7a7a7a, F8_E8_W = 0x7a7a7a7a;
__device__ __forceinline__ float f8clamp(float v) { return __builtin_amdgcn_fmed3f(v, -448.0f, 448.0f); }
__device__ __forceinline__ unsigned pk4f8(float a, float b, float c, float d) { int p = 0; p = __builtin_amdgcn_cvt_pk_fp8_f32(f8clamp(a), f8clamp(b), p, false); p = __builtin_amdgcn_cvt_pk_fp8_f32(f8clamp(c), f8clamp(d), p, true); return (unsigned)p; }
struct EpiSwiglu8 { unsigned char* H; int ldh; static constexpr bool PERM = true;
    __device__ __forceinline__ void emit8(int row, int on, int c, f32x4 lo0, f32x4 lo1, f32x4 hi0, f32x4 hi1) const {
        f32x4 v0, v1; v0.x = silu1(lo0.x) * hi0.x; v0.y = silu1(lo0.y) * hi0.y; v0.z = silu1(lo0.z) * hi0.z; v0.w = silu1(lo0.w) * hi0.w;
        v1.x = silu1(lo1.x) * hi1.x; v1.y = silu1(lo1.y) * hi1.y; v1.z = silu1(lo1.z) * hi1.z; v1.w = silu1(lo1.w) * hi1.w;
        v0 = v0 * F8_SC_H; v1 = v1 * F8_SC_H;
        *(u32x2*)(H + (size_t)row * ldh + on * 128 + c) = (u32x2){pk4f8(v0.x, v0.y, v0.z, v0.w), pk4f8(v1.x, v1.y, v1.z, v1.w)};
    }
    __device__ __forceinline__ void emit(int, int, int, f32x4, f32x4) const {} };
struct EpiPlain { bf16* O; int ldo; static constexpr bool PERM = true;
    __device__ __forceinline__ void emit8(int row, int on, int c, f32x4 lo0, f32x4 lo1, f32x4 hi0, f32x4 hi1) const {
        bf16* rp = O + (size_t)row * ldo + on * 256 + c;
        *(u32x4*)rp = pack8(lo0, lo1); *(u32x4*)(rp + 128) = pack8(hi0, hi1);
    }
    __device__ __forceinline__ void emit(int row, int on, int c, f32x4 lo, f32x4 hi) const {
        bf16* rp = O + (size_t)row * ldo + on * 256 + c;
        *(u32x2*)rp = pack4(lo); *(u32x2*)(rp + 128) = pack4(hi);
    } };

template <class Epi, class Sched>
__device__ __forceinline__ void ngemm_phase(LAS unsigned char* lds, const Gemm g, const Sched& S, const Epi& E) {
    const int tid = opaque_tid(), ty = tid >> 5, tx = tid & 31;
    LAS float* As = (LAS float*)lds;
    LAS float* Bs = As + 16 * 132;
    Unit u;
    for (int it = 0; S.next(it, u); ++it) {
        for (int half = 0; half < 2; ++half) {
            float acc[8][8];
#pragma unroll
            for (int i = 0; i < 8; ++i)
#pragma unroll
                for (int j = 0; j < 8; ++j) acc[i][j] = 0.f;
            const bf16* Ap = g.A + (size_t)(u.pm * 256 + half * 128 + (tid >> 2)) * g.lda + (tid & 3) * 4;
            const bf16* Bp = g.Bt + (size_t)(u.pn * 256 + (tid >> 1)) * g.K + (tid & 1) * 8;
            for (int k0 = 0; k0 < g.K; k0 += 16) {
                const u32x2 av = *(const u32x2*)(Ap + k0);
                const u32x4 bv = *(const u32x4*)(Bp + k0);
                __syncthreads();
                { LAS float* a = As + ((tid & 3) * 4) * 132 + (tid >> 2);
                  a[0] = bflo(av.x); a[132] = bfhi(av.x); a[264] = bflo(av.y); a[396] = bfhi(av.y);
                  LAS float* b = Bs + ((tid & 1) * 8) * 260 + (tid >> 1);
                  b[0] = bflo(bv.x); b[260] = bfhi(bv.x); b[520] = bflo(bv.y); b[780] = bfhi(bv.y);
                  b[1040] = bflo(bv.z); b[1300] = bfhi(bv.z); b[1560] = bflo(bv.w); b[1820] = bfhi(bv.w); }
                __syncthreads();
#pragma unroll 2
                for (int kk = 0; kk < 16; ++kk) {
                    const f32x4 a0 = *(const LAS f32x4*)(As + kk * 132 + ty * 8), a1 = *(const LAS f32x4*)(As + kk * 132 + ty * 8 + 4);
                    const f32x4 b0 = *(const LAS f32x4*)(Bs + kk * 260 + tx * 4), b1 = *(const LAS f32x4*)(Bs + kk * 260 + 128 + tx * 4);
                    const float a[8] = {a0.x, a0.y, a0.z, a0.w, a1.x, a1.y, a1.z, a1.w};
                    const float b[8] = {b0.x, b0.y, b0.z, b0.w, b1.x, b1.y, b1.z, b1.w};
#pragma unroll
                    for (int i = 0; i < 8; ++i)
#pragma unroll
                        for (int j = 0; j < 8; ++j) acc[i][j] += a[i] * b[j];
                }
            }
#pragma unroll
            for (int i = 0; i < 8; ++i) {
                const f32x4 lo = {acc[i][0], acc[i][1], acc[i][2], acc[i][3]}, hi = {acc[i][4], acc[i][5], acc[i][6], acc[i][7]};
                E.emit(u.om * 256 + half * 128 + ty * 8 + i, u.on, tx * 4, lo, hi);
            }
        }
    }
    __syncthreads();
}


namespace pg8 {
__device__ __forceinline__ void glds_so(unsigned long long sbase, unsigned voff, unsigned lds_dst) { unsigned keep;
    asm volatile("s_mov_b32 %0, m0\n\ts_mov_b32 m0, %3\n\ts_nop 0\n\tglobal_load_lds_dwordx4 %1, %2\n\ts_mov_b32 m0, %0" : "=&s"(keep) : "v"(voff), "s"(sbase), "s"(lds_dst) : "memory"); }
__device__ __forceinline__ void glds_so_nt(unsigned long long sbase, unsigned voff, unsigned lds_dst) { unsigned keep;
    asm volatile("s_mov_b32 %0, m0\n\ts_mov_b32 m0, %3\n\ts_nop 0\n\tglobal_load_lds_dwordx4 %1, %2 nt\n\ts_mov_b32 m0, %0" : "=&s"(keep) : "v"(voff), "s"(sbase), "s"(lds_dst) : "memory"); }
typedef short bf16x8 __attribute__((ext_vector_type(8)));
typedef int i32x4_t __attribute__((ext_vector_type(4)));
typedef int i32x8_t __attribute__((ext_vector_type(8)));
typedef short s16x16_t __attribute__((ext_vector_type(16)));
constexpr int BM = 256, BK = 64, HALF = 128, HTB = HALF * BK * 2, STAGE_BYTES = 8 * HTB;
__device__ __forceinline__ int lds_byte(int r, int c) { const int st = (r >> 4) * 2 + (c >> 5), rr = r & 15, cc = c & 31, ob = rr * 64 + cc * 2; return st * 1024 + (ob ^ (((ob >> 9) & 1) << 5)); }
__device__ __forceinline__ int perm32(int rho) { const int n = rho >> 4, i = rho & 15; return 8 * (i >> 2) + 4 * n + (i & 3); }
__device__ __forceinline__ void stage_rc(int b, int& R, int& C) { const int st = b / 1024, sb = b % 1024, swz = sb ^ (((sb >> 9) & 1) << 5); R = (st >> 1) * 16 + swz / 64; C = (st & 1) * 32 + (swz % 64) / 2; }
template <class Epi, class Sched, bool GATHER = false, bool PAIRA = false, bool F8 = false>
__device__ __forceinline__ void gemm_phase(LAS unsigned char* lds, const Gemm g, const Sched& S, const Epi& E) {
    const int tid = opaque_tid(), wid = __builtin_amdgcn_readfirstlane(tid >> 6), lane = tid & 63, wr = wid >> 2, wc = wid & 3, fr = lane & 15, fq = lane >> 4;
    const int K = g.K, nt = F8 ? K / 128 : K / BK, lda = g.lda; const int sc2 = g.sa;
    unsigned voffA[2], voffB[2];
#pragma unroll
    for (int i = 0; i < 2; ++i) { int R, C; stage_rc(tid * 16 + i * 8192, R, C); const int Rb = Epi::PERM ? ((R & ~31) + perm32(R & 31)) : R;
        voffA[i] = F8 ? (unsigned)(R * lda + 2 * C) : PAIRA ? (unsigned)((R >> 1) * (2 * lda) + (C >> 5) * 64 + (R & 1) * 32 + (C & 31)) * 2u : (unsigned)(R * lda + C) * 2u; voffB[i] = F8 ? (unsigned)(Rb * K + 2 * C) : (unsigned)(Rb * K + C) * 2u; }
    const size_t kstep = (size_t)(BK * 2), kstepA = PAIRA ? 2 * kstep : kstep;
    const size_t hstepA = (size_t)HALF * lda * (F8 ? 1 : 2), hstepB = (size_t)HALF * K * (F8 ? 1 : 2);
    const size_t tstepA = 2 * hstepA, tstepB = 2 * hstepB;
    const unsigned ldsw = (unsigned)wid * 1024u;
    const unsigned ldsb = (unsigned)__builtin_amdgcn_readfirstlane((int)((unsigned)(uintptr_t)lds + ldsw));
    const int loff = F8 ? lds_byte(fr, fq * 16) : lds_byte(fr, fq * 8); const int aoff = wr * 8192 + loff, boff = wc * 4096 + loff;
#define PG8_SA(b, h) (((b) * 2 + (h)) * HTB)
#define PG8_SB(b, h) ((4 + (b) * 2 + (h)) * HTB)
#define PG8_STAGE(bufoff, gbase, voff) do { \
        if constexpr (F8) { const unsigned long long b_ = (unsigned long long)(gbase); \
            const unsigned long long sb_ = ((unsigned long long)(unsigned)__builtin_amdgcn_readfirstlane((int)(b_ >> 32)) << 32) | (unsigned)__builtin_amdgcn_readfirstlane((int)b_); \
            const bool isB_ = ((const void*)(voff) == (const void*)voffB), isA_ = ((const void*)(voff) == (const void*)voffA);     \
            if (isB_ || isA_) { const unsigned long long d_ = 64ull * (unsigned)(isB_ ? K : lda);     \
                if (isA_ && !GATHER) { glds_so_nt(sb_, (voff)[0], ldsb + (unsigned)(bufoff)); glds_so_nt(sb_ + d_, (voff)[0], ldsb + (unsigned)((bufoff) + 8192)); }     \
                else { glds_so(sb_, (voff)[0], ldsb + (unsigned)(bufoff)); glds_so(sb_ + d_, (voff)[0], ldsb + (unsigned)((bufoff) + 8192)); } } \
            else { _Pragma("unroll") for (int _i = 0; _i < 2; ++_i) glds_so(sb_, (voff)[_i], ldsb + (unsigned)((bufoff) + _i * 8192)); } }     \
        else { _Pragma("unroll") for (int _i = 0; _i < 2; ++_i) __builtin_amdgcn_global_load_lds((const unsigned*)((const char*)(gbase) + (voff)[_i]), (LAS unsigned*)(lds + (bufoff) + ldsw + _i * 8192), 16, 0, 0); } } while (0)
#define PG8_LDA(dst, b, h) do { if constexpr (F8) { _Pragma("unroll") for (int m = 0; m < 4; ++m) dst##8[m] = __builtin_bit_cast(i32x8_t, *(const LAS s16x16_t*)(lds + PG8_SA(b, h) + aoff + m * 2048)); } \
        else { _Pragma("unroll") for (int m = 0; m < 4; ++m) _Pragma("unroll") for (int k = 0; k < 2; ++k) dst[m][k] = *(const LAS bf16x8*)(lds + PG8_SA(b, h) + aoff + m * 2048 + k * 1024); } } while (0)
#define PG8_LDB(dst, b, h) do { if constexpr (F8) { _Pragma("unroll") for (int n = 0; n < 2; ++n) dst##8[n] = __builtin_bit_cast(i32x8_t, *(const LAS s16x16_t*)(lds + PG8_SB(b, h) + boff + n * 2048)); } \
        else { _Pragma("unroll") for (int n = 0; n < 2; ++n) _Pragma("unroll") for (int k = 0; k < 2; ++k) dst[n][k] = *(const LAS bf16x8*)(lds + PG8_SB(b, h) + boff + n * 2048 + k * 1024); } } while (0)
#define PG8_CAT(a_, b_) __builtin_shufflevector(__builtin_bit_cast(i32x4_t, a_), __builtin_bit_cast(i32x4_t, b_), 0, 1, 2, 3, 4, 5, 6, 7)
#define PG8_MMA(ai, bj, At, Bt) do { __builtin_amdgcn_s_setprio(1); \
        if constexpr (F8) { _Pragma("unroll") for (int m = 0; m < 4; ++m) _Pragma("unroll") for (int n = 0; n < 2; ++n) \
            acc[ai][bj][m][n] = __builtin_amdgcn_mfma_scale_f32_16x16x128_f8f6f4(Bt##8[n], At##8[m], acc[ai][bj][m][n], 0, 0, 0, sc2, 0, sc2); } \
        else { _Pragma("unroll") for (int m = 0; m < 4; ++m) _Pragma("unroll") for (int n = 0; n < 2; ++n) _Pragma("unroll") for (int k = 0; k < 2; ++k) \
            acc[ai][bj][m][n] = __builtin_amdgcn_mfma_f32_16x16x32_bf16(Bt[n][k], At[m][k], acc[ai][bj][m][n], 0, 0, 0); } \
        __builtin_amdgcn_s_setprio(0); } while (0)
#define PG8_WAIT_V(n) asm volatile("s_waitcnt vmcnt(" #n ")" ::: "memory")
#define PG8_WAIT_L(n) asm volatile("s_waitcnt lgkmcnt(" #n ")" ::: "memory")
#define PG8_BAR __builtin_amdgcn_s_barrier()
#define PG8_SCHED __builtin_amdgcn_sched_barrier(0)
    Unit cur, nxt; int ui = 0;
    if (!S.next(0, cur)) return;
    unsigned gA0[2] = {0u, 0u}, gA1[2] = {0u, 0u};
    const char* gbaseA = (const char*)g.A;
#define PG8_GLOAD(u, r) do { _Pragma("unroll") for (int i_ = 0; i_ < 2; ++i_) { int R_, C_; stage_rc(tid * 16 + i_ * 8192, R_, C_); const int* tp_ = S.rowtok + ((u).ge * 32768 + (u).gl * 256 + R_); r[2 * i_] = tp_[0]; r[2 * i_ + 1] = tp_[128]; } } while (0)
#define PG8_GOFF(r, o0, o1) do { _Pragma("unroll") for (int i_ = 0; i_ < 2; ++i_) { int R_, C_; stage_rc(tid * 16 + i_ * 8192, R_, C_); o0[i_] = F8 ? (unsigned)(r[2 * i_] * lda + 2 * C_) : (unsigned)(r[2 * i_] * lda + C_) * 2u; o1[i_] = F8 ? (unsigned)(r[2 * i_ + 1] * lda + 2 * C_) : (unsigned)(r[2 * i_ + 1] * lda + C_) * 2u; } } while (0)
#define PG8_STAGE_A(bufoff, ptr, kofs, offs) do { if constexpr (GATHER) PG8_STAGE(bufoff, gbaseA + (kofs), offs); else PG8_STAGE(bufoff, ptr, voffA); } while (0)
    int raw[4] = {0, 0, 0, 0};
    if constexpr (GATHER) { PG8_GLOAD(cur, raw); PG8_GOFF(raw, gA0, gA1); }
    f32x4 acc[2][2][4][2];
#pragma unroll
    for (int a = 0; a < 2; ++a)
#pragma unroll
        for (int b = 0; b < 2; ++b)
#pragma unroll
            for (int m = 0; m < 4; ++m)
#pragma unroll
                for (int n = 0; n < 2; ++n) acc[a][b][m][n] = (f32x4){0.f, 0.f, 0.f, 0.f};
    bf16x8 At[4][2], B0[2][2], B1[2][2]; i32x8_t At8[4], B08[2], B18[2];
#define PG8_SPTR(p_) (F8 ? (const char*)(((unsigned long long)(unsigned)__builtin_amdgcn_readfirstlane((int)((unsigned long long)(p_) >> 32)) << 32) | (unsigned)__builtin_amdgcn_readfirstlane((int)(unsigned long long)(p_))) : (const char*)(p_))
    const char* cA = PG8_SPTR((const char*)g.A + (size_t)cur.pm * tstepA); const char* cB = PG8_SPTR((const char*)g.Bt + (size_t)cur.pn * tstepB);
    S.a_ready(cur);
    PG8_STAGE(PG8_SB(0, 0), cB, voffB); PG8_STAGE(PG8_SB(0, 1), cB + hstepB, voffB); PG8_STAGE_A(PG8_SA(0, 0), cA, 0, gA0); PG8_STAGE_A(PG8_SA(0, 1), cA + hstepA, 0, gA1);
    if (wr == 1) PG8_BAR;
    PG8_WAIT_V(2); PG8_BAR;
    PG8_STAGE(PG8_SB(1, 0), cB + kstep, voffB); PG8_STAGE_A(PG8_SA(1, 0), cA + kstepA, kstep, gA0); PG8_STAGE(PG8_SB(1, 1), cB + hstepB + kstep, voffB);
    PG8_WAIT_V(6); PG8_BAR;
    for (;;) {
        const bool has_next = S.next(ui + 1, nxt);
        const char* nA = PG8_SPTR(has_next ? (const char*)g.A + (size_t)nxt.pm * tstepA : cA); const char* nB = PG8_SPTR(has_next ? (const char*)g.Bt + (size_t)nxt.pn * tstepB : cB);
        const bool gsw = GATHER && has_next && (nxt.ge != cur.ge || nxt.gl != cur.gl);
#pragma unroll 1
        for (int t = 0; t < nt; t += 2) {
            const bool last = (t == nt - 2);
            const size_t k1 = (size_t)(t + 1) * kstep, k2 = last ? (size_t)0 : (size_t)(t + 2) * kstep, k3 = k2 + kstep;
            const char* a1 = cA + (size_t)(t + 1) * kstepA;
            const char* a2 = last ? nA : cA + (size_t)(t + 2) * kstepA; const char* b2 = last ? nB : cB + (size_t)(t + 2) * kstep;
            const char* a3 = a2 + kstepA; const char* b3 = b2 + kstep;
            if (last && has_next) S.a_ready(nxt);
            PG8_LDB(B0, 0, 0); PG8_LDB(B1, 0, 1); PG8_SCHED; PG8_LDA(At, 0, 0); PG8_STAGE_A(PG8_SA(1, 1), a1 + hstepA, k1, gA1);
            if constexpr (GATHER) { if (last && gsw) { PG8_GLOAD(nxt, raw); PG8_GOFF(raw, gA0, gA1); } }
            PG8_WAIT_V(8); PG8_WAIT_L(0); PG8_BAR; PG8_MMA(0, 0, At, B0); PG8_MMA(0, 1, At, B1); PG8_BAR; PG8_SCHED;
            PG8_LDA(At, 0, 1); PG8_STAGE(PG8_SB(0, 0), b2, voffB); PG8_STAGE(PG8_SB(0, 1), b2 + hstepB, voffB); PG8_STAGE_A(PG8_SA(0, 0), a2, k2, gA0);
            PG8_WAIT_V(8); PG8_WAIT_L(0); PG8_BAR; PG8_MMA(1, 0, At, B0); PG8_MMA(1, 1, At, B1); PG8_BAR; PG8_SCHED;
            PG8_LDB(B0, 1, 0); PG8_LDB(B1, 1, 1); PG8_SCHED; PG8_LDA(At, 1, 0); PG8_STAGE_A(PG8_SA(0, 1), a2 + hstepA, k2, gA1);
            PG8_WAIT_V(8); PG8_WAIT_L(0); PG8_BAR; PG8_MMA(0, 0, At, B0); PG8_MMA(0, 1, At, B1); PG8_BAR; PG8_SCHED;
            PG8_LDA(At, 1, 1); PG8_STAGE(PG8_SB(1, 0), b3, voffB); PG8_STAGE(PG8_SB(1, 1), b3 + hstepB, voffB); PG8_STAGE_A(PG8_SA(1, 0), a3, k3, gA0);
            PG8_WAIT_V(8); PG8_WAIT_L(0); PG8_BAR; PG8_MMA(1, 0, At, B0); PG8_MMA(1, 1, At, B1); PG8_BAR; PG8_SCHED;
        }
        if (wr == 0) PG8_BAR;
        {
            int fr_e = fr, fq_e = fq;
            if constexpr (F8) { const int l2_ = opaque_tid() & 63; fr_e = l2_ & 15; fq_e = l2_ >> 4; }
#pragma unroll
            for (int ai = 0; ai < 2; ++ai)
#pragma unroll
                for (int m = 0; m < 4; ++m) { const int row = cur.om * BM + ai * HALF + wr * 64 + m * 16 + fr_e;
                    if constexpr (Epi::PERM) E.emit8(row, cur.on, wc * 32 + 8 * fq_e, acc[ai][0][m][0], acc[ai][0][m][1], acc[ai][1][m][0], acc[ai][1][m][1]);
                    else {
#pragma unroll
                    for (int n = 0; n < 2; ++n) E.emit(row, cur.on, wc * 32 + n * 16 + fq * 4, acc[ai][0][m][n], acc[ai][1][m][n]); } }
            S.done(cur);
        }
        if (!has_next) break;
#pragma unroll
        for (int a = 0; a < 2; ++a)
#pragma unroll
            for (int b = 0; b < 2; ++b)
#pragma unroll
                for (int m = 0; m < 4; ++m)
#pragma unroll
                    for (int n = 0; n < 2; ++n) acc[a][b][m][n] = (f32x4){0.f, 0.f, 0.f, 0.f};
        cur = nxt; cA = nA; cB = nB; ++ui;
        if (wr == 1) PG8_BAR;
    }
    PG8_WAIT_V(0);
    PG8_BAR;
#undef PG8_SA
#undef PG8_SB
#undef PG8_STAGE
#undef PG8_STAGE_A
#undef PG8_SPTR
#undef PG8_GLOAD
#undef PG8_GOFF
#undef PG8_LDA
#undef PG8_LDB
#undef PG8_MMA
#undef PG8_CAT
#undef PG8_WAIT_V
#undef PG8_WAIT_L
#undef PG8_BAR
#undef PG8_SCHED
}
}
#ifndef USE_NAIVE_GEMM
#define GEMM_PHASE pg8::gemm_phase
#else
#define GEMM_PHASE ngemm_phase
#endif

struct Args { const float* in[24]; float* out; unsigned char* ws; };
enum { I_X = 0, I_WIN, I_WOUT, I_GWS, I_GBS, I_LQ1, I_LK1, I_LQ2, I_LK2, I_SUBG, I_RELB, I_POOLW, I_POOLS, I_LN1G, I_LN1B, I_LN2G, I_LN2B,
       I_FW1, I_FW3, I_FW2, I_RW, I_MW1, I_MW3, I_MW2 };

__device__ __forceinline__ void tr_item8(const float* src, int ld, int k0s, int n0s, unsigned char* dst, int ldd, int n0d, int k0d, LAS float* scr, int lane) {
#pragma unroll 8
    for (int i = 0; i < 32; ++i) { const int kk = 2 * i + (lane >> 5); scr[kk * 33 + (lane & 31)] = __builtin_nontemporal_load(src + (size_t)(k0s + kk) * ld + n0s + (lane & 31)) * F8_SC_W; }
    asm volatile("s_waitcnt lgkmcnt(0)" ::: "memory");
    const int c = lane & 3;
#pragma unroll
    for (int j = 0; j < 2; ++j) { const int n = (lane >> 2) + 16 * j; const LAS float* q = scr + (16 * c) * 33 + n;
        u32x4 o; o.x = pk4f8(q[0 * 33], q[1 * 33], q[2 * 33], q[3 * 33]); o.y = pk4f8(q[4 * 33], q[5 * 33], q[6 * 33], q[7 * 33]);
        o.z = pk4f8(q[8 * 33], q[9 * 33], q[10 * 33], q[11 * 33]); o.w = pk4f8(q[12 * 33], q[13 * 33], q[14 * 33], q[15 * 33]);
        *(u32x4*)(dst + (size_t)(n0d + n) * ldd + k0d + 16 * c) = o; }
    asm volatile("s_waitcnt lgkmcnt(0)" ::: "memory");
}
__device__ __forceinline__ void tr_item(const float* src, int ld, int k0s, int n0s, bf16* dst, int ldd, int n0d, int k0d, LAS float* scr, int lane) {
#pragma unroll 8
    for (int i = 0; i < 32; ++i) { const int kk = 2 * i + (lane >> 5); scr[kk * 33 + (lane & 31)] = __builtin_nontemporal_load(src + (size_t)(k0s + kk) * ld + n0s + (lane & 31)); }
    asm volatile("s_waitcnt lgkmcnt(0)" ::: "memory");
    const int c = lane & 7;
#pragma unroll
    for (int j = 0; j < 4; ++j) { const int n = (lane >> 3) + 8 * j; const LAS float* s = scr + (8 * c) * 33 + n;
        u32x4 o; o.x = pk2(s[0 * 33], s[1 * 33]); o.y = pk2(s[2 * 33], s[3 * 33]); o.z = pk2(s[4 * 33], s[5 * 33]); o.w = pk2(s[6 * 33], s[7 * 33]);
        *(u32x4*)(dst + (size_t)(n0d + n) * ldd + k0d + 8 * c) = o; }
    asm volatile("s_waitcnt lgkmcnt(0)" ::: "memory");
}

__device__ __forceinline__ void prologue(const Args& a, LAS unsigned char* lds, int gw, int NGW, int wave, int lane_) {
    int lane = lane_; asm volatile("" : "+v"(lane));
    unsigned char* ws = a.ws;
    LAS float* scr = (LAS float*)(lds + wave * 16384);
    for (int i = gw * 64 + lane; i < 2 * 4 * 128 * 128; i += NGW * 64) { const int s_ = i & 127, t_ = (i >> 7) & 127; ((bf16*)(ws + WS_WB))[i] = (s_ <= t_) ? (bf16)f2bf(a.in[I_GWS][i]) : (bf16)0; }
    for (int i = gw * 64 + lane; i < 2 * 4 * 64 * 64; i += NGW * 64) { const int c_ = i & 63, d_ = (i >> 6) & 63, lg = i >> 12; ((bf16*)(ws + WS_PWT))[i] = (bf16)f2bf(a.in[I_POOLW][lg * 4096 + c_ * 64 + d_]); }
    for (int i = gw * 64 + lane; i < 8 * 32768; i += NGW * 64) ((int*)(ws + WS_ROWTOK))[i] = 0;
    constexpr int N_WIN = 16 * 72, N_WOUT = 16 * 32, N_W13 = 176 * 16, N_W2 = 44 * 32, N_MW13 = 224 * 16, N_MW2 = 56 * 32;
    constexpr int TOT = 2 * N_WIN + 2 * N_WOUT + N_W13 + N_W2 + 8 * N_MW13 + 8 * N_MW2;
    for (int it = gw; it < TOT; it += NGW) {
        int r = it;
        if (r < 2 * N_WIN) { const int l = r / N_WIN; r %= N_WIN; const int kb = r / 72, nb = r % 72;
            tr_item(a.in[I_WIN] + (size_t)l * DM * DIN, DIN, 64 * kb, 32 * nb, (bf16*)(ws + WS_WIN) + (size_t)l * DIN * DM, DM, 32 * nb, 64 * kb, scr, lane); continue; }
        r -= 2 * N_WIN;
        if (r < 2 * N_WOUT) { const int l = r / N_WOUT; r %= N_WOUT; const int kb = r / 32, nb = r % 32; const int kd = 64 * kb;
            const int ks = kd < 256 ? kd : (kd < 512 ? kd + 512 : kd - 256);
            tr_item(a.in[I_WOUT] + (size_t)l * DM * DM, DM, ks, 32 * nb, (bf16*)(ws + WS_WOUT) + (size_t)l * DM * DM, DM, 32 * nb, kd, scr, lane); continue; }
        r -= 2 * N_WOUT;
        if (r < N_W13) { const int nb = r / 16, kb = r % 16; const int nd = 32 * nb, t = nd >> 8, s = (nd >> 7) & 1, j0 = nd & 127;
            tr_item(a.in[s ? I_FW3 : I_FW1], DFF, 64 * kb, 128 * t + j0, (bf16*)(ws + WS_W13), DM, nd, 64 * kb, scr, lane); continue; }
        r -= N_W13;
        if (r < N_W2) { const int kb = r / 32, nb = r % 32;
            tr_item8(a.in[I_FW2], DM, 64 * kb, 32 * nb, (unsigned char*)(ws + WS_W2), DFF, 32 * nb, 64 * kb, scr, lane); continue; }
        r -= N_W2;
        if (r < 8 * N_MW13) { const int e = r / N_MW13; r %= N_MW13; const int nb = r / 16, kb = r % 16; const int nd = 32 * nb, t = nd >> 8, s = (nd >> 7) & 1, j0 = nd & 127;
            tr_item8(a.in[s ? I_MW3 : I_MW1] + (size_t)e * DM * DFE, DFE, 64 * kb, 128 * t + j0, (unsigned char*)(ws + WS_MW13) + (size_t)e * 2 * DFE * DM, DM, nd, 64 * kb, scr, lane); continue; }
        r -= 8 * N_MW13;
        { const int e = r / N_MW2; r %= N_MW2; const int kb = r / 32, nb = r % 32;
            tr_item8(a.in[I_MW2] + (size_t)e * DFE * DM, DM, 64 * kb, 32 * nb, (unsigned char*)(ws + WS_MW2) + (size_t)e * DM * DFE, DFE, 32 * nb, 64 * kb, scr, lane); }
    }
    bf16* xb = (bf16*)(ws + WS_XB);
    for (int m0 = gw; m0 < M; m0 += 4 * NGW) {
        f32x4 xv[4][4];
#pragma unroll
        for (int k = 0; k < 4; ++k) { const f32x4* xr = (const f32x4*)(a.in[I_X] + (size_t)(m0 + k * NGW) * DM) + lane;
#pragma unroll
            for (int j = 0; j < 4; ++j) xv[k][j] = __builtin_nontemporal_load(xr + 64 * j); }
#pragma unroll
        for (int k = 0; k < 4; ++k) { u32x2* o = (u32x2*)(xb + (size_t)(m0 + k * NGW) * DM) + lane;
#pragma unroll
            for (int j = 0; j < 4; ++j) o[64 * j] = pack4(xv[k][j]); }
    }
}

__device__ __forceinline__ void chunk_unit(LAS unsigned char* lds, bf16* P, int chunk, const bf16* Wb, const float* gbs, const bf16* PwT, const float* psc) {
    typedef pg8::bf16x8 bf16x8;
    const int tid = opaque_tid(), lane = tid & 63, wv = __builtin_amdgcn_readfirstlane(tid >> 6), fr = lane & 15, fq = lane >> 4;
    const size_t r0 = (size_t)chunk * 128;
    const int tpos0 = (chunk % (SEQ / 128)) * 128;
    const int trow = 16 * wv + fr;
    {
        LAS bf16* VnT = (LAS bf16*)lds;
        const int nks = (wv >> 1) + 1;
        for (int h = 0; h < 4; ++h) {
            __syncthreads();
            {   const int sI = tid >> 2, qd = (tid & 3) * 16;
                const bf16* vp = P + (r0 + sI) * PP + PC_V + h * 64 + qd;
                const u32x4 w0 = *(const u32x4*)vp, w1 = *(const u32x4*)(vp + 8);
                float v[16] = {bflo(w0.x), bfhi(w0.x), bflo(w0.y), bfhi(w0.y), bflo(w0.z), bfhi(w0.z), bflo(w0.w), bfhi(w0.w),
                               bflo(w1.x), bfhi(w1.x), bflo(w1.y), bfhi(w1.y), bflo(w1.z), bfhi(w1.z), bflo(w1.w), bfhi(w1.w)};
                float sum = 0.f;
#pragma unroll
                for (int i = 0; i < 16; ++i) sum += v[i];
                sum += shx(sum, lane, 1); sum += shx(sum, lane, 2);
                const float mu = sum * (1.f / 64.f); float sq = 0.f;
#pragma unroll
                for (int i = 0; i < 16; ++i) { v[i] -= mu; sq += v[i] * v[i]; }
                sq += shx(sq, lane, 1); sq += shx(sq, lane, 2);
                const float rstd = 1.0f / sqrtf(sq * (1.f / 64.f) + LN_EPS);
#pragma unroll
                for (int i = 0; i < 16; ++i) VnT[(qd + i) * 136 + sI] = (bf16)f2bf(v[i] * rstd);
            }
            bf16x8 af[4];
#pragma unroll
            for (int ks = 0; ks < 4; ++ks) af[ks] = (ks < nks) ? *(const bf16x8*)(Wb + ((size_t)(h * 128 + trow) * 128 + 32 * ks + 8 * fq)) : (bf16x8){0, 0, 0, 0, 0, 0, 0, 0};
            __syncthreads();
            f32x4 acc[4];
#pragma unroll
            for (int j = 0; j < 4; ++j) acc[j] = (f32x4){0.f, 0.f, 0.f, 0.f};
#pragma unroll
            for (int ks = 0; ks < 4; ++ks) if (ks < nks) {
#pragma unroll
                for (int j = 0; j < 4; ++j) { const bf16x8 bfr = *(const LAS bf16x8*)(VnT + (16 * j + fr) * 136 + 32 * ks + 8 * fq);
                    acc[j] = __builtin_amdgcn_mfma_f32_16x16x32_bf16(bfr, af[ks], acc[j], 0, 0, 0); } }
            const float bias = gbs[h * 128 + trow];
#pragma unroll
            for (int j = 0; j < 4; ++j) { bf16* up = P + (r0 + trow) * PP + PC_U + h * 64 + 16 * j + 4 * fq; const u32x2 uw = *(const u32x2*)up;
                f32x4 o; o.x = bflo(uw.x) * (acc[j].x + bias); o.y = bfhi(uw.x) * (acc[j].y + bias); o.z = bflo(uw.y) * (acc[j].z + bias); o.w = bfhi(uw.y) * (acc[j].w + bias);
                *(u32x2*)up = pack4(o); }
        }
    }
    {
        LAS float* Cs = (LAS float*)lds;
        LAS bf16* Yb = (LAS bf16*)(lds + 40960);
        for (int g = 0; g < 4; ++g) {
            __syncthreads();
            for (int idx = tid; idx < 143 * 8; idx += NTHR) { const int rr = idx >> 3, c8 = (idx & 7) * 8, trel = rr - 15;
                f32x4 a = {0.f, 0.f, 0.f, 0.f}, b = {0.f, 0.f, 0.f, 0.f};
                if (tpos0 + trel >= 0) { const u32x4 w = *(const u32x4*)(P + (size_t)((long)r0 + trel) * PP + PC_C + g * 64 + c8);
                    a = (f32x4){bflo(w.x), bfhi(w.x), bflo(w.y), bfhi(w.y)}; b = (f32x4){bflo(w.z), bfhi(w.z), bflo(w.w), bfhi(w.w)}; }
                *(LAS f32x4*)(Cs + rr * 64 + c8) = a; *(LAS f32x4*)(Cs + rr * 64 + c8 + 4) = b; }
            bf16x8 bfr[4][2];
#pragma unroll
            for (int j = 0; j < 4; ++j)
#pragma unroll
                for (int ks = 0; ks < 2; ++ks) bfr[j][ks] = *(const bf16x8*)(PwT + ((size_t)(g * 64 + 16 * j + fr) * 64 + 32 * ks + 8 * fq));
            __syncthreads();
            {   const int t = tid >> 2, cq = (tid & 3) * 16, win = 2 << g; const int tp = tpos0 + t; const int cnt = (tp + 1) < win ? (tp + 1) : win;
                const float rc = 1.0f / (float)cnt;
#pragma unroll
                for (int i = 0; i < 4; ++i) { f32x4 sm = {0.f, 0.f, 0.f, 0.f};
                    for (int j = 0; j < cnt; ++j) sm += *(const LAS f32x4*)(Cs + (t + 15 - j) * 64 + cq + 4 * i);
                    const f32x4 self = *(const LAS f32x4*)(Cs + (t + 15) * 64 + cq + 4 * i);
                    *(LAS u32x2*)(Yb + t * 72 + cq + 4 * i) = pack4(sm * rc - self); }
            }
            __syncthreads();
            f32x4 acc[4];
#pragma unroll
            for (int j = 0; j < 4; ++j) acc[j] = (f32x4){0.f, 0.f, 0.f, 0.f};
#pragma unroll
            for (int ks = 0; ks < 2; ++ks) { const bf16x8 af = *(const LAS bf16x8*)(Yb + trow * 72 + 32 * ks + 8 * fq);
#pragma unroll
                for (int j = 0; j < 4; ++j) acc[j] = __builtin_amdgcn_mfma_f32_16x16x32_bf16(bfr[j][ks], af, acc[j], 0, 0, 0); }
#pragma unroll
            for (int j = 0; j < 4; ++j) { const int d = 16 * j + 4 * fq; const f32x4 sc = *(const f32x4*)(psc + g * 64 + d);
                *(u32x2*)(P + (r0 + trow) * PP + PC_V + g * 64 + d) = pack4(acc[j] * sc); }
        }
    }
    __syncthreads();
}

__device__ __forceinline__ int t5_bucket(int n) {
    if (n < 16) return n;
    int v = 16 + (int)(logf((float)n * (1.0f / 16.0f)) * (16.0f / 2.0794415416798357f));
    return v < 31 ? v : 31;
}
__device__ __forceinline__ void nattn_unit(LAS unsigned char* lds, bf16* P, int b, int h, int qt, const LAS float* btab, float lam, const float* subg, float omli) {
    const int tid = opaque_tid(), row = tid >> 3, m = (tid >> 2) & 1, dq = tid & 3;
    LAS float* Ks = (LAS float*)lds;
    LAS float* Vs = Ks + 64 * 128;
    const size_t rowq = (size_t)b * SEQ + qt * 64 + row;
    float q[16];
    {   const bf16* qp = P + rowq * PP + PC_Q + h * 128 + m * 64 + dq * 16;
#pragma unroll
        for (int i = 0; i < 2; ++i) { const u32x4 v = *(const u32x4*)(qp + 8 * i);
            q[8 * i] = bflo(v.x); q[8 * i + 1] = bfhi(v.x); q[8 * i + 2] = bflo(v.y); q[8 * i + 3] = bfhi(v.y); q[8 * i + 4] = bflo(v.z); q[8 * i + 5] = bfhi(v.z); q[8 * i + 6] = bflo(v.w); q[8 * i + 7] = bfhi(v.w); } }
    float o[32];
#pragma unroll
    for (int d = 0; d < 32; ++d) o[d] = 0.f;
    float mr = -INFINITY, l = 0.f;
    const int qpos = qt * 64 + row;
    for (int kt = 0; kt <= qt; ++kt) {
        __syncthreads();
        {   const int key = tid >> 3, c16 = (tid & 7) * 16;
            const bf16* kp = P + ((size_t)b * SEQ + kt * 64 + key) * PP + PC_K + h * 128 + c16;
            const u32x4 k0 = *(const u32x4*)kp, k1 = *(const u32x4*)(kp + 8), v0 = *(const u32x4*)(kp + 512), v1 = *(const u32x4*)(kp + 520);
            LAS float* kd = Ks + key * 128 + c16; LAS float* vd = Vs + key * 128 + c16;
            *(LAS f32x4*)(kd) = (f32x4){bflo(k0.x), bfhi(k0.x), bflo(k0.y), bfhi(k0.y)}; *(LAS f32x4*)(kd + 4) = (f32x4){bflo(k0.z), bfhi(k0.z), bflo(k0.w), bfhi(k0.w)};
            *(LAS f32x4*)(kd + 8) = (f32x4){bflo(k1.x), bfhi(k1.x), bflo(k1.y), bfhi(k1.y)}; *(LAS f32x4*)(kd + 12) = (f32x4){bflo(k1.z), bfhi(k1.z), bflo(k1.w), bfhi(k1.w)};
            *(LAS f32x4*)(vd) = (f32x4){bflo(v0.x), bfhi(v0.x), bflo(v0.y), bfhi(v0.y)}; *(LAS f32x4*)(vd + 4) = (f32x4){bflo(v0.z), bfhi(v0.z), bflo(v0.w), bfhi(v0.w)};
            *(LAS f32x4*)(vd + 8) = (f32x4){bflo(v1.x), bfhi(v1.x), bflo(v1.y), bfhi(v1.y)}; *(LAS f32x4*)(vd + 12) = (f32x4){bflo(v1.z), bfhi(v1.z), bflo(v1.w), bfhi(v1.w)};
        }
        __syncthreads();
        const int kbase = kt * 64;
        for (int j0 = 0; j0 < 64; j0 += 4) {
            float s[4];
#pragma unroll
            for (int jj = 0; jj < 4; ++jj) { const LAS float* kr = Ks + (j0 + jj) * 128 + m * 64 + dq * 16; float a = 0.f;
#pragma unroll
                for (int d = 0; d < 16; d += 4) { const f32x4 kv = *(const LAS f32x4*)(kr + d); a += q[d] * kv.x + q[d + 1] * kv.y + q[d + 2] * kv.z + q[d + 3] * kv.w; }
                a += __shfl_xor(a, 1); a += __shfl_xor(a, 2); s[jj] = a; }
            float gm = mr;
#pragma unroll
            for (int jj = 0; jj < 4; ++jj) { const int dist = qpos - (kbase + j0 + jj);
                if (dist < 0) s[jj] = -INFINITY; else if (dist < 128) s[jj] += btab[dist];
                gm = fmaxf(gm, s[jj]); }
            const float sc = __builtin_amdgcn_exp2f(mr - gm);
            mr = gm; l *= sc;
#pragma unroll
            for (int d = 0; d < 32; ++d) o[d] *= sc;
#pragma unroll
            for (int jj = 0; jj < 4; ++jj) { const float pj = __builtin_amdgcn_exp2f(s[jj] - gm); l += pj;
                const LAS float* vr = Vs + (j0 + jj) * 128 + dq * 32;
#pragma unroll
                for (int d = 0; d < 32; d += 4) { const f32x4 vv = *(const LAS f32x4*)(vr + d); o[d] += pj * vv.x; o[d + 1] += pj * vv.y; o[d + 2] += pj * vv.z; o[d + 3] += pj * vv.w; } }
        }
    }
    {   const float rl = 1.0f / l; float ss = 0.f;
#pragma unroll
        for (int d = 0; d < 32; ++d) { const float y = o[d] * rl; const float oth = __shfl_xor(y, 4); o[d] = y - lam * oth; ss += o[d] * o[d]; }
        ss += __shfl_xor(ss, 1); ss += __shfl_xor(ss, 2);
        const float rs = (1.0f / sqrtf(ss * (1.f / 128.f) + LN_EPS)) * omli;
        if (m == 0) {
            bf16* yp = P + rowq * PP + PC_Q + h * 128 + dq * 32; const float* gp = subg + dq * 32;
#pragma unroll
            for (int i = 0; i < 4; ++i) { u32x4 w;
                w.x = pk2(o[8 * i] * rs * gp[8 * i], o[8 * i + 1] * rs * gp[8 * i + 1]); w.y = pk2(o[8 * i + 2] * rs * gp[8 * i + 2], o[8 * i + 3] * rs * gp[8 * i + 3]);
                w.z = pk2(o[8 * i + 4] * rs * gp[8 * i + 4], o[8 * i + 5] * rs * gp[8 * i + 5]); w.w = pk2(o[8 * i + 6] * rs * gp[8 * i + 6], o[8 * i + 7] * rs * gp[8 * i + 7]);
                *(u32x4*)(yp + 8 * i) = w; }
        }
    }
    __syncthreads();
}

#include <hip/hip_bf16.h>
#include <cmath>
namespace attn_body {
using bf16=__hip_bfloat16;
using bf16x8=__attribute__((ext_vector_type(8)))short;
using s16x4=__attribute__((ext_vector_type(4)))short;
using f32x16=__attribute__((ext_vector_type(16)))float;
using u32x4=__attribute__((ext_vector_type(4)))unsigned;
constexpr int SEQ=16384,D=64;
constexpr int NW=8,QBLK=32,QB=QBLK*NW,KVBLK=64,NQB=SEQ/QB;
constexpr int PQ=2304,PO=1024,ATTN_UNIT_ROWS=QB;
__device__ __forceinline__ int crow(int r,int hi){return (r&3)+8*(r>>2)+4*hi;}
#define SBAR() __builtin_amdgcn_sched_barrier(0)
__device__ __forceinline__ void cmask(f32x16&p0,f32x16&p1,int jb,int qrel,int hi){
  const float NEG=-INFINITY; int kb=64*jb+4*hi;
  #pragma unroll
  for(int r=0;r<16;++r){int kv=kb+(r&3)+8*(r>>2); if(kv>qrel)p0[r]=NEG; if(kv+32>qrel)p1[r]=NEG;}
}

constexpr int NSLOT=3, SLOTB=8192;
constexpr int LDS_K=0, LDS_V=NSLOT*SLOTB, LDS_WS=2*NSLOT*SLOTB, LDS_OST=LDS_WS+NW*64*4, LDS_BYTES=LDS_OST+NW*4096;
constexpr float C2=0.125f*1.4426950408889634f;
__device__ __forceinline__ void glds16(const void*gsrc,unsigned lds_dst){unsigned keep;
  asm volatile("s_mov_b32 %0, m0\n\ts_mov_b32 m0, %2\n\ts_nop 0\n\tglobal_load_lds_dwordx4 %1, off\n\ts_mov_b32 m0, %0":"=&s"(keep):"v"(gsrc),"s"(lds_dst):"memory");}
__device__ __forceinline__ float max3f(float a,float b,float c){float r;asm("v_max3_f32 %0, %1, %2, %3":"=v"(r):"v"(a),"v"(b),"v"(c));return r;}
__device__ __forceinline__ float max2f(float a,float b){float r;asm("v_max_f32_e32 %0, %1, %2":"=v"(r):"v"(a),"v"(b));return r;}
__device__ __forceinline__ float fadd_s(float a,float b){float r;asm("v_add_f32_e32 %0, %1, %2":"=v"(r):"v"(a),"v"(b));return r;}
__device__ __forceinline__ float fsub_s(float a,float b){float r;asm("v_sub_f32_e32 %0, %1, %2":"=v"(r):"v"(a),"v"(b));return r;}
__device__ __forceinline__ float fmul_s(float a,float b){float r;asm("v_mul_f32_e32 %0, %1, %2":"=v"(r):"v"(a),"v"(b));return r;}
typedef float f32x2_t __attribute__((ext_vector_type(2))); typedef __bf16 bf16x2_t __attribute__((ext_vector_type(2)));
__device__ __forceinline__ unsigned cvtpk_s(float lo,float hi){f32x2_t v={lo,hi};bf16x2_t b=__builtin_convertvector(v,bf16x2_t);return __builtin_bit_cast(unsigned,b);}
#define WAIT_BAR(N) asm volatile("s_waitcnt vmcnt(" #N ") lgkmcnt(0)\n\ts_barrier":::"memory")

__device__ __forceinline__ void qkt(f32x16&p0,f32x16&p1,const char*Kslot,const bf16x8*qr,const f32x16&negm,int r32,int hi){
  const char*kb=Kslot+hi*1024+r32*16;
  #pragma unroll
  for(int d0=0;d0<4;++d0){
    const bf16x8 b0=*reinterpret_cast<const bf16x8*>(kb+d0*2048);
    const bf16x8 b1=*reinterpret_cast<const bf16x8*>(kb+d0*2048+512);
    if(d0==0){p0=__builtin_amdgcn_mfma_f32_32x32x16_bf16(b0,qr[0],negm,0,0,0);p1=__builtin_amdgcn_mfma_f32_32x32x16_bf16(b1,qr[0],negm,0,0,0);}
    else{p0=__builtin_amdgcn_mfma_f32_32x32x16_bf16(b0,qr[d0],p0,0,0,0);p1=__builtin_amdgcn_mfma_f32_32x32x16_bf16(b1,qr[d0],p1,0,0,0);}}
}
typedef __attribute__((address_space(3))) const char* lds_cptr;
typedef short v4i16_t __attribute__((ext_vector_type(4)));
__device__ __forceinline__ void kload8(bf16x8*kf,lds_cptr kp){
  kf[0]=*(const __attribute__((address_space(3))) bf16x8*)(kp);      kf[1]=*(const __attribute__((address_space(3))) bf16x8*)(kp+512);
  kf[2]=*(const __attribute__((address_space(3))) bf16x8*)(kp+2048); kf[3]=*(const __attribute__((address_space(3))) bf16x8*)(kp+2560);
  kf[4]=*(const __attribute__((address_space(3))) bf16x8*)(kp+4096); kf[5]=*(const __attribute__((address_space(3))) bf16x8*)(kp+4608);
  kf[6]=*(const __attribute__((address_space(3))) bf16x8*)(kp+6144); kf[7]=*(const __attribute__((address_space(3))) bf16x8*)(kp+6656);
}
__device__ __forceinline__ void kload2(bf16x8*kf,lds_cptr kp,int j){ kf[2*j]=*(const __attribute__((address_space(3))) bf16x8*)(kp+j*2048); kf[2*j+1]=*(const __attribute__((address_space(3))) bf16x8*)(kp+j*2048+512); }
__device__ __forceinline__ s16x4 vtr(lds_cptr p){ return __builtin_bit_cast(s16x4,__builtin_amdgcn_ds_read_tr16_b64_v4i16((__attribute__((address_space(3))) v4i16_t*)p)); }
__device__ __forceinline__ float rowmax(const f32x16&p0,const f32x16&p1){
  float a=max3f(p0[0],p0[1],p1[0]),b=max3f(p0[2],p0[3],p1[1]);a=max3f(a,p1[2],p1[3]);
  #pragma unroll
  for(int r=4;r<16;r+=4){a=max3f(a,p0[r],p0[r+1]);b=max3f(b,p0[r+2],p0[r+3]);a=max3f(a,p1[r],p1[r+1]);b=max3f(b,p1[r+2],p1[r+3]);}
  const float m=max2f(a,b);
  auto rr=__builtin_amdgcn_permlane32_swap(__float_as_uint(m),__float_as_uint(m),false,false);
  return max2f(__uint_as_float(rr[0]),__uint_as_float(rr[1]));
}
__device__ __forceinline__ void pv(f32x16*o,int vb,bf16x8 pa0,bf16x8 pa1,bf16x8 pa2,bf16x8 pa3){
  #pragma unroll
  for(int d0=0;d0<2;++d0){s16x4 lo[4],hi[4];
    #pragma unroll
    for(int ks=0;ks<4;++ks){
      asm volatile("ds_read_b64_tr_b16 %0,%1 offset:%c2":"=&v"(lo[ks]):"v"(vb),"i"(d0*4096+ks*1024):"memory");
      asm volatile("ds_read_b64_tr_b16 %0,%1 offset:%c2":"=&v"(hi[ks]):"v"(vb),"i"(d0*4096+ks*1024+512):"memory");}
    asm volatile("s_waitcnt lgkmcnt(0)":::"memory");SBAR();
    #define PK(k) (bf16x8){lo[k][0],lo[k][1],lo[k][2],lo[k][3],hi[k][0],hi[k][1],hi[k][2],hi[k][3]}
    o[d0]=__builtin_amdgcn_mfma_f32_32x32x16_bf16(pa0,PK(0),o[d0],0,0,0);
    o[d0]=__builtin_amdgcn_mfma_f32_32x32x16_bf16(pa1,PK(1),o[d0],0,0,0);
    o[d0]=__builtin_amdgcn_mfma_f32_32x32x16_bf16(pa2,PK(2),o[d0],0,0,0);
    o[d0]=__builtin_amdgcn_mfma_f32_32x32x16_bf16(pa3,PK(3),o[d0],0,0,0);
    #undef PK
  }
}

#ifndef ATTN_STORE16
#define ATTN_STORE16(p,v) (*(u32x4*)(p)=(v))
#endif
template<int THRL> __device__ __forceinline__ void attn_unit(int b,int qb,const bf16*Q,const bf16*__restrict__ K,const bf16*__restrict__ V,bf16*O,const __attribute__((address_space(3))) float*xtab,char*shm){
  int tid=threadIdx.x; asm volatile("":"+v"(tid)); asm volatile("":"+s"(qb)); asm volatile("":"+s"(b));
  const int lane=tid&63,r32=lane&31,hi=lane>>5; const int wid=__builtin_amdgcn_readfirstlane(tid>>6);
  const long rowbase=(long)b*SEQ; const int q0=qb*QB;
  const bf16*Qw=Q+(rowbase+q0+wid*QBLK)*PQ;
  const bf16*Kh=K+rowbase*PQ,*Vh=V+rowbase*PQ;
  const unsigned lds0=(unsigned)(uintptr_t)shm;
  float*wsf=(float*)(shm+LDS_WS)+wid*64;
  const bf16*ksrc=Kh+(long)lane*PQ+wid*8;
  const bf16*vsrc=Vh+(long)(16*(wid&3)+(lane>>2))*PQ+(wid>>2)*32+(lane&3)*8;
  const unsigned kdst=lds0+LDS_K+wid*1024, vdst=lds0+LDS_V+wid*1024;
  #define DMA_K(t,slot) glds16(ksrc+(long)(t)*KVBLK*PQ,(unsigned)__builtin_amdgcn_readfirstlane(kdst+(slot)))
  #define DMA_V(t,slot) glds16(vsrc+(long)(t)*KVBLK*PQ,(unsigned)__builtin_amdgcn_readfirstlane(vdst+(slot)))
  const int vb0=(int)(lds0+LDS_V)+((lane>>4)&1)*32+(lane&3)*8+(4*hi+((lane&15)>>2))*64;
  const char*Kbase=shm+LDS_K; bf16x8 kf[8];
  const lds_cptr shm3=(lds_cptr)shm; const lds_cptr kp0=shm3+LDS_K+hi*1024+r32*16; const lds_cptr vp0=shm3+LDS_V+((lane>>4)&1)*32+(lane&3)*8+(4*hi+((lane&15)>>2))*64;
  const int NT=(q0+QB)/KVBLK;
  DMA_K(0,0);DMA_V(0,0);DMA_K(1,SLOTB);
  bf16x8 qr[4];
  #pragma unroll
  for(int d0=0;d0<4;++d0)qr[d0]=*reinterpret_cast<const bf16x8*>(&Qw[(long)r32*PQ+d0*16+hi*8]);
  float mhat=0.f,l_reg=0.f;f32x16 o[2];o[0]=f32x16{};o[1]=f32x16{};f32x16 negm=f32x16{};asm volatile("":"+v"(negm));
  const int qrel=wid*QBLK+r32;
  #define CMASK(P0,P1,t) do{int jb_=(t)-(NT-4); if(jb_>=0)cmask(P0,P1,jb_,qrel,hi);}while(0)
  #define CBIAS_ON(P0,P1,t) do{ if((t)>=NT-6){ const __attribute__((address_space(3))) float*tb_=xtab+(q0+qrel-64*(t)-4*hi+(256-59)); \
      _Pragma("unroll") for(int g_=0;g_<4;++g_){ float b0_[4],b1_[4]; \
        _Pragma("unroll") for(int i_=0;i_<4;++i_){ b0_[i_]=tb_[59-(i_+8*g_)]; b1_[i_]=tb_[27-(i_+8*g_)]; } \
        _Pragma("unroll") for(int i_=0;i_<4;++i_){ P0[4*g_+i_]=fadd_s(P0[4*g_+i_],b0_[i_]); P1[4*g_+i_]=fadd_s(P1[4*g_+i_],b1_[i_]); } \
        asm volatile("":"+v"(P0),"+v"(P1)); SBAR(); } } }while(0)
  #define CBIAS(P0,P1,t) CBIAS_ON(P0,P1,t)
  bool resc=false;
  #define START(P0,P1) do{ const float rm=rowmax(P0,P1); resc=false; \
    { const float dl=rm; mhat=fadd_s(mhat,dl); \
      _Pragma("unroll") for(int r=0;r<16;++r){P0[r]=fsub_s(P0[r],dl);P1[r]=fsub_s(P1[r],dl);} \
      _Pragma("unroll") for(int r=0;r<16;++r)negm[r]=-mhat; asm volatile("":"+v"(negm)); } \
    _Pragma("unroll") for(int r=0;r<16;++r)P0[r]=__builtin_amdgcn_exp2f(P0[r]); }while(0)
  #define RESC() do{ if(resc){ asm volatile("s_waitcnt lgkmcnt(0)":::"memory"); \
      _Pragma("unroll") for(int d_=0;d_<2;++d_) _Pragma("unroll") for(int r=0;r<16;++r)o[d_][r]*=wsf[crow(r,hi)]; } }while(0)
  f32x16 pA0,pA1,pB0,pB1;
  int sl_prev=0,sl_cur=0,sl_next=SLOTB;
  #define ROT() do{sl_prev=sl_cur;sl_cur=sl_next;sl_next=(sl_next==(NSLOT-1)*SLOTB)?0:sl_next+SLOTB;}while(0)
  DMA_K(2,2*SLOTB);
  WAIT_BAR(3);
  qkt(pA0,pA1,Kbase,qr,negm,r32,hi);asm volatile("s_nop 15\n\ts_nop 7":"+v"(pA0),"+v"(pA1));CMASK(pA0,pA1,0);CBIAS(pA0,pA1,0);
  START(pA0,pA1);
  _Pragma("unroll") for(int r=0;r<16;++r)pA1[r]=__builtin_amdgcn_exp2f(pA1[r]);
  WAIT_BAR(0);
  DMA_K(3,0);DMA_V(1,SLOTB);
  ROT();
  kload8(kf,kp0+sl_cur);
  WAIT_BAR(2);
  s16x4 vlo[8],vhi[8]; u32x4 pw0,pw1,pw2,pw3;
  #define PKW(P,B) cvtpk_s(P[B],P[B+1])
  #define PAF(k) __builtin_bit_cast(bf16x8,pw##k)
  #define VFR(i) (bf16x8){vlo[i][0],vlo[i][1],vlo[i][2],vlo[i][3],vhi[i][0],vhi[i][1],vhi[i][2],vhi[i][3]}
  #define PIN(x) asm volatile("":"+v"(x))
  #define MX3(a,b,c) __builtin_fmaxf(__builtin_fmaxf((a),(b)),(c))
  #define GAPA(MF,A0,A1,A2,A3,W0,W1,PW) do{ MF; sacc+=A0; sacc+=A1; sacc+=A2; sacc+=A3; PIN(sacc); W0; W1; PIN(PW); SBAR(); }while(0)
  #define EX(v) __builtin_amdgcn_exp2f(v)
  #define GAPB(MF,X,B) do{ MF; X[B]=EX(X[B]); X[B+1]=EX(X[B+1]); X[B+2]=EX(X[B+2]); X[B+3]=EX(X[B+3]); PIN(X); SBAR(); }while(0)
  #define VRD(i) do{ vlo[i]=vtr(vp_+(((i)>>2)*4096+((i)&3)*1024)); vhi[i]=vtr(vp_+(((i)>>2)*4096+((i)&3)*1024+512)); }while(0)
  #define KRD(G,j) do{ if(G){ kload2(kf,kp0+sl_next,j); SBAR(); } }while(0)
  #define STEP(C0,C1,P0,P1,t,GK,GV,GL) do{ SBAR(); \
    const lds_cptr vp_=vp0+sl_prev; \
    VRD(0); SBAR(); float sacc=(P0[0]+P0[1]); \
    GAPA(C0=__builtin_amdgcn_mfma_f32_32x32x16_bf16(kf[0],qr[0],negm,0,0,0), P0[2],P0[3],P0[4],P0[5],     pw0[0]=PKW(P0,0), pw0[1]=PKW(P0,2), pw0); \
    VRD(4); SBAR(); GAPA(C1=__builtin_amdgcn_mfma_f32_32x32x16_bf16(kf[1],qr[0],negm,0,0,0), P0[6],P0[7],P0[8],P0[9],     pw0[2]=PKW(P0,4), pw0[3]=PKW(P0,6), pw0); \
    VRD(1); SBAR(); GAPA(C0=__builtin_amdgcn_mfma_f32_32x32x16_bf16(kf[2],qr[1],C0,0,0,0),   P0[10],P0[11],P0[12],P0[13], pw1[0]=PKW(P0,8), pw1[1]=PKW(P0,10), pw1); \
    VRD(5); SBAR(); GAPA(C1=__builtin_amdgcn_mfma_f32_32x32x16_bf16(kf[3],qr[1],C1,0,0,0),   P0[14],P0[15],P1[0],P1[1],   pw1[2]=PKW(P0,12),pw1[3]=PKW(P0,14), pw1); \
    VRD(2); SBAR(); GAPA(C0=__builtin_amdgcn_mfma_f32_32x32x16_bf16(kf[4],qr[2],C0,0,0,0),   P1[2],P1[3],P1[4],P1[5],     pw2[0]=PKW(P1,0), pw2[1]=PKW(P1,2), pw2); \
    VRD(6); SBAR(); GAPA(C1=__builtin_amdgcn_mfma_f32_32x32x16_bf16(kf[5],qr[2],C1,0,0,0),   P1[6],P1[7],P1[8],P1[9],     pw2[2]=PKW(P1,4), pw2[3]=PKW(P1,6), pw2); \
    VRD(3); SBAR(); GAPA(C0=__builtin_amdgcn_mfma_f32_32x32x16_bf16(kf[6],qr[3],C0,0,0,0),   P1[10],P1[11],P1[12],P1[13], pw3[0]=PKW(P1,8), pw3[1]=PKW(P1,10), pw3); \
    VRD(7); SBAR(); GAPA(C1=__builtin_amdgcn_mfma_f32_32x32x16_bf16(kf[7],qr[3],C1,0,0,0),   P1[14],P1[15],0.f,0.f,       pw3[2]=PKW(P1,12),pw3[3]=PKW(P1,14), pw3); \
    l_reg+=sacc; \
    if(GK){DMA_K((t)+3,sl_cur);} if(GV){DMA_V((t)+1,sl_next);} \
    CMASK(C0,C1,t); CBIAS(C0,C1,t); \
    { float a=MX3(C0[0],C0[1],C1[0]),b=MX3(C0[2],C0[3],C1[1]); a=MX3(a,C1[2],C1[3]); \
      _Pragma("unroll") for(int r=4;r<16;r+=4){a=MX3(a,C0[r],C0[r+1]);b=MX3(b,C0[r+2],C0[r+3]);a=MX3(a,C1[r],C1[r+1]);b=MX3(b,C1[r+2],C1[r+3]);} \
      float rm=__builtin_fmaxf(a,b); { auto rr=__builtin_amdgcn_permlane32_swap(__float_as_uint(rm),__float_as_uint(rm),false,false); rm=__builtin_fmaxf(__uint_as_float(rr[0]),__uint_as_float(rr[1])); } \
      resc=false; \
      if(__builtin_expect(__any(rm>(float)THRL),0)){ const float dl=__builtin_fmaxf(rm,0.f); mhat+=dl; \
        _Pragma("unroll") for(int r=0;r<16;++r){C0[r]-=dl;C1[r]-=dl;} \
        _Pragma("unroll") for(int r=0;r<16;++r)negm[r]=-mhat; asm volatile("":"+v"(negm)); \
        const float f=__builtin_amdgcn_exp2f(-dl); l_reg*=f; if(hi==0)wsf[r32]=f; resc=true; } } \
    SBAR(); \
    GAPB(o[0]=__builtin_amdgcn_mfma_f32_32x32x16_bf16(PAF(0),VFR(0),o[0],0,0,0), C0,0); \
    GAPB(o[1]=__builtin_amdgcn_mfma_f32_32x32x16_bf16(PAF(0),VFR(4),o[1],0,0,0), C0,4); \
    KRD(GL,0); GAPB(o[0]=__builtin_amdgcn_mfma_f32_32x32x16_bf16(PAF(1),VFR(1),o[0],0,0,0), C0,8); \
    KRD(GL,1); GAPB(o[1]=__builtin_amdgcn_mfma_f32_32x32x16_bf16(PAF(1),VFR(5),o[1],0,0,0), C0,12); \
    KRD(GL,2); GAPB(o[0]=__builtin_amdgcn_mfma_f32_32x32x16_bf16(PAF(2),VFR(2),o[0],0,0,0), C1,0); \
    KRD(GL,3); GAPB(o[1]=__builtin_amdgcn_mfma_f32_32x32x16_bf16(PAF(2),VFR(6),o[1],0,0,0), C1,4); \
    GAPB(o[0]=__builtin_amdgcn_mfma_f32_32x32x16_bf16(PAF(3),VFR(3),o[0],0,0,0), C1,8); \
    GAPB(o[1]=__builtin_amdgcn_mfma_f32_32x32x16_bf16(PAF(3),VFR(7),o[1],0,0,0), C1,12); \
    }while(0)
  int t=1;
  #undef CMASK
  #undef CBIAS
  #define CMASK(P0,P1,t) do{}while(0)
  #define CBIAS(P0,P1,t) do{}while(0)
  for(;t+7<NT;t+=2){
    STEP(pB0,pB1,pA0,pA1,t,true,true,true);     WAIT_BAR(2); RESC(); ROT();
    STEP(pA0,pA1,pB0,pB1,t+1,true,true,true);   WAIT_BAR(2); RESC(); ROT();
  }
  #undef CMASK
  #undef CBIAS
  #define CMASK(P0,P1,t) do{int jb_=(t)-(NT-4); if(jb_>=0)cmask(P0,P1,jb_,qrel,hi);}while(0)
  #define CBIAS(P0,P1,t) CBIAS_ON(P0,P1,t)
  #define ENDW(tt) do{ if((tt)+3<NT){WAIT_BAR(2);} else if((tt)+2<NT){WAIT_BAR(1);} else {WAIT_BAR(0);} }while(0)
  for(;t+1<NT;t+=2){
    STEP(pB0,pB1,pA0,pA1,t,(t+3<NT),(t+1<NT),(t+1<NT));       ENDW(t);   RESC(); ROT();
    STEP(pA0,pA1,pB0,pB1,t+1,(t+4<NT),(t+2<NT),(t+2<NT));     ENDW(t+1); RESC(); ROT();
  }
  STEP(pB0,pB1,pA0,pA1,NT-1,false,false,false); RESC();
  { float sacc=pB0[0]+pB0[1]; _Pragma("unroll") for(int r=2;r<16;++r)sacc+=pB0[r]; _Pragma("unroll") for(int r=0;r<16;++r)sacc+=pB1[r]; l_reg+=sacc;
    pw0=(u32x4){PKW(pB0,0),PKW(pB0,2),PKW(pB0,4),PKW(pB0,6)};pw1=(u32x4){PKW(pB0,8),PKW(pB0,10),PKW(pB0,12),PKW(pB0,14)};pw2=(u32x4){PKW(pB1,0),PKW(pB1,2),PKW(pB1,4),PKW(pB1,6)};pw3=(u32x4){PKW(pB1,8),PKW(pB1,10),PKW(pB1,12),PKW(pB1,14)};
    SBAR(); pv(o,vb0+sl_cur,PAF(0),PAF(1),PAF(2),PAF(3)); }
  #undef PKW
  #undef PAF
  #undef VFR
  #undef PIN
  #undef MX3
  #undef GAPA
  #undef GAPB
  #undef EX
  #undef VRD
  #undef KRD
  #undef STEP
  #undef ENDW
  {auto rr=__builtin_amdgcn_permlane32_swap(__float_as_uint(l_reg),__float_as_uint(l_reg),false,false);l_reg=__uint_as_float(rr[0])+__uint_as_float(rr[1]);}
  if(hi==0)wsf[32+r32]=l_reg;asm volatile("s_waitcnt lgkmcnt(0)":::"memory");
  float rli[16];
  #pragma unroll
  for(int r=0;r<16;++r)rli[r]=__builtin_amdgcn_rcpf(wsf[32+crow(r,hi)]);
  bf16*Ow=O+(rowbase+q0+wid*QBLK)*PO;
  { bf16*stg=(bf16*)(shm+LDS_OST)+wid*2048;
    #pragma unroll
    for(int r=0;r<16;++r){const int orow=crow(r,hi);
      #pragma unroll
      for(int d0=0;d0<2;++d0)stg[orow*64+d0*32+r32]=__float2bfloat16(o[d0][r]*rli[r]);}
    asm volatile("s_waitcnt lgkmcnt(0)":::"memory");
    #pragma unroll
    for(int i=0;i<4;++i){const int row=i*8+(lane>>3),ch=lane&7; const u32x4 v=*(const u32x4*)(stg+row*64+ch*8); ATTN_STORE16(Ow+(long)row*PO+ch*8,v);} }
  asm volatile("s_waitcnt lgkmcnt(0)\n\ts_barrier":::"memory");
  #undef DMA_K
  #undef DMA_V
  #undef CMASK
  #undef CBIAS
  #undef CBIAS_ON
  #undef START
  #undef RESC
  #undef ROT
}

constexpr int VSLOT=16384, NSLOTV=4, L2_K=0, L2_V=NSLOT*SLOTB, L2_WS=L2_V+NSLOTV*VSLOT, L2_OST=L2_WS+NW*64*4, L2_BYTES=L2_OST+NW*4096;
template<int THRL> __device__ __forceinline__ void attn_unit2(int b,int qb,const bf16*Q,const bf16*__restrict__ K,const bf16*__restrict__ V,bf16*O,const __attribute__((address_space(3))) float*xtab,char*shm){
  int tid=threadIdx.x; asm volatile("":"+v"(tid)); asm volatile("":"+s"(qb)); asm volatile("":"+s"(b));
  const int lane=tid&63,r32=lane&31,hi=lane>>5; const int wid=__builtin_amdgcn_readfirstlane(tid>>6);
  const long rowbase=(long)b*SEQ; const int q0=qb*QB;
  const bf16*Qw=Q+(rowbase+q0+wid*QBLK)*PQ;
  const bf16*Kh=K+rowbase*PQ,*Vh=V+rowbase*PQ;
  const unsigned lds0=(unsigned)(uintptr_t)shm;
  float*wsf=(float*)(shm+L2_WS)+wid*64;
  const bf16*ksrc=Kh+(long)lane*PQ+wid*8;
  const bf16*vsrc=Vh+(long)(16*(wid&3)+(lane>>2))*PQ+(wid>>2)*32+(lane&3)*8;
  const unsigned kdst=lds0+L2_K+wid*1024, vdst=lds0+L2_V+wid*1024;
  #define DMA_K(t,slot) glds16(ksrc+(long)(t)*KVBLK*PQ,(unsigned)__builtin_amdgcn_readfirstlane(kdst+(slot)))
  #define DMA_V(t,voff) do{ glds16(vsrc+(long)(t)*KVBLK*PQ,(unsigned)__builtin_amdgcn_readfirstlane(vdst+(voff))); glds16(vsrc+64+(long)(t)*KVBLK*PQ,(unsigned)__builtin_amdgcn_readfirstlane(vdst+(voff)+8192)); }while(0)
  const int vb0=(int)(lds0+L2_V)+((lane>>4)&1)*32+(lane&3)*8+(4*hi+((lane&15)>>2))*64;
  const char*Kbase=shm+L2_K; bf16x8 kf[8];
  const lds_cptr shm3=(lds_cptr)shm; const lds_cptr kp0=shm3+L2_K+hi*1024+r32*16; const lds_cptr vp0=shm3+L2_V+((lane>>4)&1)*32+(lane&3)*8+(4*hi+((lane&15)>>2))*64;
  const int NT=(q0+QB)/KVBLK;
  DMA_K(0,0);DMA_V(0,0);DMA_K(1,SLOTB);
  bf16x8 qr[4];
  #pragma unroll
  for(int d0=0;d0<4;++d0)qr[d0]=*reinterpret_cast<const bf16x8*>(&Qw[(long)r32*PQ+d0*16+hi*8]);
  float mhat=0.f,l_reg=0.f;f32x16 o[4];o[0]=f32x16{};o[1]=f32x16{};o[2]=f32x16{};o[3]=f32x16{};
  const int qrel=wid*QBLK+r32;
  #define CMASK(P0,P1,t) do{int jb_=(t)-(NT-4); if(jb_>=0)cmask(P0,P1,jb_,qrel,hi);}while(0)
  #define CBIAS_ON(P0,P1,t) do{ if((t)>=NT-6){ const __attribute__((address_space(3))) float*tb_=xtab+(q0+qrel-64*(t)-4*hi+(256-59)); \
      _Pragma("unroll") for(int g_=0;g_<4;++g_){ float b0_[4],b1_[4]; \
        _Pragma("unroll") for(int i_=0;i_<4;++i_){ b0_[i_]=tb_[59-(i_+8*g_)]; b1_[i_]=tb_[27-(i_+8*g_)]; } \
        _Pragma("unroll") for(int i_=0;i_<4;++i_){ P0[4*g_+i_]=fadd_s(P0[4*g_+i_],b0_[i_]); P1[4*g_+i_]=fadd_s(P1[4*g_+i_],b1_[i_]); } \
        asm volatile("":"+v"(P0),"+v"(P1)); SBAR(); } } }while(0)
  #define CBIAS(P0,P1,t) CBIAS_ON(P0,P1,t)
  bool resc=false;
  #define START(P0,P1) do{ const float rm=rowmax(P0,P1); resc=false; \
    { const float dl=rm; mhat=fadd_s(mhat,dl); \
      _Pragma("unroll") for(int r=0;r<16;++r){P0[r]=fsub_s(P0[r],dl);P1[r]=fsub_s(P1[r],dl);} \
      } \
    _Pragma("unroll") for(int r=0;r<16;++r)P0[r]=__builtin_amdgcn_exp2f(P0[r]); }while(0)
  #define RESC() do{ if(resc){ asm volatile("s_waitcnt lgkmcnt(0)":::"memory"); \
      _Pragma("unroll") for(int r=0;r<16;++r){ const float f_=wsf[crow(r,hi)]; _Pragma("unroll") for(int d_=0;d_<4;++d_) o[d_][r]=fmul_s(o[d_][r],f_); } } }while(0)
  f32x16 c0,c1; f32x16 negm;
  int sl_prev=0,sl_cur=0,sl_next=SLOTB; int vs_prev=0,vs_dma=3*VSLOT;
  #define ROT() do{sl_prev=sl_cur;sl_cur=sl_next;sl_next=(sl_next==(NSLOT-1)*SLOTB)?0:sl_next+SLOTB; vs_prev=(vs_prev+VSLOT)&(NSLOTV*VSLOT-1); vs_dma=(vs_dma+VSLOT)&(NSLOTV*VSLOT-1);}while(0)
  DMA_K(2,2*SLOTB);DMA_V(1,VSLOT);
  WAIT_BAR(6);
  s16x4 vlo[8],vhi[8]; u32x4 pw0,pw1,pw2,pw3;
  #define PKW(P,B) cvtpk_s(P[B],P[B+1])
  #define PAF(k) __builtin_bit_cast(bf16x8,pw##k)
  { const f32x16 zero16=f32x16{}; qkt(c0,c1,Kbase,qr,zero16,r32,hi); }asm volatile("s_nop 15\n\ts_nop 7":"+v"(c0),"+v"(c1));CMASK(c0,c1,0);CBIAS(c0,c1,0);
  START(c0,c1);
  { const float nm_=-mhat; _Pragma("unroll") for(int r=0;r<16;++r)negm[r]=nm_; }
  _Pragma("unroll") for(int r=0;r<16;++r)c1[r]=__builtin_amdgcn_exp2f(c1[r]);
  { float sacc=c0[0]+c0[1]; _Pragma("unroll") for(int r=2;r<16;++r)sacc+=c0[r]; _Pragma("unroll") for(int r=0;r<16;++r)sacc+=c1[r]; l_reg+=sacc;
    pw0=(u32x4){PKW(c0,0),PKW(c0,2),PKW(c0,4),PKW(c0,6)};pw1=(u32x4){PKW(c0,8),PKW(c0,10),PKW(c0,12),PKW(c0,14)};pw2=(u32x4){PKW(c1,0),PKW(c1,2),PKW(c1,4),PKW(c1,6)};pw3=(u32x4){PKW(c1,8),PKW(c1,10),PKW(c1,12),PKW(c1,14)}; }
  WAIT_BAR(0);
  DMA_K(3,0);DMA_V(2,2*VSLOT);
  sl_prev=sl_cur;sl_cur=sl_next;sl_next=2*SLOTB;
  kload8(kf,kp0+sl_cur);
  WAIT_BAR(3);
  #define VFR(i) (bf16x8){vlo[i][0],vlo[i][1],vlo[i][2],vlo[i][3],vhi[i][0],vhi[i][1],vhi[i][2],vhi[i][3]}
  #define PIN(x) asm volatile("":"+v"(x))
  #define MX3(a,b,c) __builtin_fmaxf(__builtin_fmaxf((a),(b)),(c))
  #define MFM(a,b,c) __builtin_amdgcn_mfma_f32_32x32x16_bf16(a,b,c,0,0,0)
  #define GAPA(MF) do{ MF; SBAR(); }while(0)
  #define EX(v) __builtin_amdgcn_exp2f(v)
  #define GAPB(MF,X,B) do{ MF; X[B]=EX(X[B]); X[B+1]=EX(X[B+1]); X[B+2]=EX(X[B+2]); X[B+3]=EX(X[B+3]); PIN(X); SBAR(); }while(0)
  #define GAPS(MF,A0,A1,A2,A3) do{ MF; sacc+=A0; sacc+=A1; sacc+=A2; sacc+=A3; PIN(sacc); SBAR(); }while(0)
  #define GAPC(MF,A0,A1,A2,A3,W0,W1,PW) do{ MF; sacc+=A0; sacc+=A1; sacc+=A2; sacc+=A3; PIN(sacc); W0; W1; PIN(PW); SBAR(); }while(0)
  #define VRD(i) do{ vlo[i]=vtr(vp_+(((i)>>2)*4096+((i)&3)*1024)); vhi[i]=vtr(vp_+(((i)>>2)*4096+((i)&3)*1024+512)); }while(0)
  #define VRD2(i) do{ vlo[i]=vtr(vp_+(8192+((i)>>2)*4096+((i)&3)*1024)); vhi[i]=vtr(vp_+(8192+((i)>>2)*4096+((i)&3)*1024+512)); }while(0)
  #define KRD(G,j) do{ if(G){ kload2(kf,kp0+sl_next,j); SBAR(); } }while(0)
  #define STEP2(t,GK,GV,GL) do{ SBAR(); \
    const lds_cptr vp_=vp0+vs_prev; \
    VRD(0); SBAR(); GAPA(c0=MFM(kf[0],qr[0],negm)); \
    VRD(4); SBAR(); GAPA(c1=MFM(kf[1],qr[0],negm)); \
    VRD(1); SBAR(); GAPA(c0=MFM(kf[2],qr[1],c0)); \
    VRD(5); SBAR(); GAPA(c1=MFM(kf[3],qr[1],c1)); \
    VRD(2); SBAR(); GAPA(c0=MFM(kf[4],qr[2],c0)); \
    VRD(6); SBAR(); GAPA(c1=MFM(kf[5],qr[2],c1)); \
    VRD(3); SBAR(); GAPA(c0=MFM(kf[6],qr[3],c0)); \
    VRD(7); SBAR(); GAPA(c1=MFM(kf[7],qr[3],c1)); \
    if(GK){DMA_K((t)+3,sl_cur);} if(GV){DMA_V((t)+2,vs_dma);} \
    CMASK(c0,c1,t); CBIAS(c0,c1,t); \
    { float a=MX3(c0[0],c0[1],c1[0]),b=MX3(c0[2],c0[3],c1[1]); a=MX3(a,c1[2],c1[3]); \
      _Pragma("unroll") for(int r=4;r<16;r+=4){a=MX3(a,c0[r],c0[r+1]);b=MX3(b,c0[r+2],c0[r+3]);a=MX3(a,c1[r],c1[r+1]);b=MX3(b,c1[r+2],c1[r+3]);} \
      float rm=__builtin_fmaxf(a,b); { auto rr=__builtin_amdgcn_permlane32_swap(__float_as_uint(rm),__float_as_uint(rm),false,false); rm=__builtin_fmaxf(__uint_as_float(rr[0]),__uint_as_float(rr[1])); } \
      resc=false; \
      if(__builtin_expect(__any(rm>(float)THRL),0)){ const float dl=__builtin_fmaxf(rm,0.f); mhat+=dl; { const float nm_=-mhat; _Pragma("unroll") for(int r=0;r<16;++r)negm[r]=nm_; } \
        _Pragma("unroll") for(int r=0;r<16;++r){c0[r]-=dl;c1[r]-=dl;} \
        const float f=__builtin_amdgcn_exp2f(-dl); l_reg*=f; if(hi==0)wsf[r32]=f; resc=true; } } \
    SBAR(); \
    GAPB(o[0]=MFM(PAF(0),VFR(0),o[0]), c0,0); \
    VRD2(0); SBAR(); GAPB(o[1]=MFM(PAF(0),VFR(4),o[1]), c0,4); \
    VRD2(4); SBAR(); GAPB(o[0]=MFM(PAF(1),VFR(1),o[0]), c0,8); \
    VRD2(1); SBAR(); GAPB(o[1]=MFM(PAF(1),VFR(5),o[1]), c0,12); \
    VRD2(5); SBAR(); GAPB(o[0]=MFM(PAF(2),VFR(2),o[0]), c1,0); \
    VRD2(2); SBAR(); GAPB(o[1]=MFM(PAF(2),VFR(6),o[1]), c1,4); \
    VRD2(6); SBAR(); GAPB(o[0]=MFM(PAF(3),VFR(3),o[0]), c1,8); \
    VRD2(3); SBAR(); GAPB(o[1]=MFM(PAF(3),VFR(7),o[1]), c1,12); \
    float sacc=(c0[0]+c0[1]); \
    VRD2(7); SBAR(); GAPS(o[2]=MFM(PAF(0),VFR(0),o[2]), c0[2],c0[3],c0[4],c0[5]); \
    KRD(GL,0); GAPS(o[3]=MFM(PAF(0),VFR(4),o[3]), c0[6],c0[7],c0[8],c0[9]); \
    KRD(GL,1); GAPC(o[2]=MFM(PAF(1),VFR(1),o[2]), c0[10],c0[11],c0[12],c0[13], pw0[0]=PKW(c0,0), pw0[1]=PKW(c0,2), pw0); \
    KRD(GL,2); GAPC(o[3]=MFM(PAF(1),VFR(5),o[3]), c0[14],c0[15],c1[0],c1[1],   pw0[2]=PKW(c0,4), pw0[3]=PKW(c0,6), pw0); \
    KRD(GL,3); GAPC(o[2]=MFM(PAF(2),VFR(2),o[2]), c1[2],c1[3],c1[4],c1[5],     pw1[0]=PKW(c0,8), pw1[1]=PKW(c0,10), pw1); \
    GAPC(o[3]=MFM(PAF(2),VFR(6),o[3]), c1[6],c1[7],c1[8],c1[9],     pw1[2]=PKW(c0,12),pw1[3]=PKW(c0,14), pw1); \
    GAPC(o[2]=MFM(PAF(3),VFR(3),o[2]), c1[10],c1[11],c1[12],c1[13], pw2[0]=PKW(c1,0), pw2[1]=PKW(c1,2), pw2); \
    GAPC(o[3]=MFM(PAF(3),VFR(7),o[3]), c1[14],c1[15],0.f,0.f,       pw2[2]=PKW(c1,4), pw2[3]=PKW(c1,6), pw2); \
    pw3[0]=PKW(c1,8); pw3[1]=PKW(c1,10); pw3[2]=PKW(c1,12); pw3[3]=PKW(c1,14); PIN(pw3); \
    l_reg+=sacc; \
    }while(0)
  int t=1;
  #undef CMASK
  #undef CBIAS
  #define CMASK(P0,P1,t) do{}while(0)
  #define CBIAS(P0,P1,t) do{}while(0)
  for(;t+7<NT;t+=2){
    STEP2(t,true,true,true);     WAIT_BAR(3); RESC(); ROT();
    STEP2(t+1,true,true,true);   WAIT_BAR(3); RESC(); ROT();
  }
  #undef CMASK
  #undef CBIAS
  #define CMASK(P0,P1,t) do{int jb_=(t)-(NT-4); if(jb_>=0)cmask(P0,P1,jb_,qrel,hi);}while(0)
  #define CBIAS(P0,P1,t) CBIAS_ON(P0,P1,t)
  #define ENDW(tt) do{ if((tt)+3<NT){WAIT_BAR(3);} else if((tt)+2<NT){WAIT_BAR(2);} else {WAIT_BAR(0);} }while(0)
  for(;t+1<NT;t+=2){
    STEP2(t,(t+3<NT),(t+2<NT),(t+1<NT));       ENDW(t);   RESC(); ROT();
    STEP2(t+1,(t+4<NT),(t+3<NT),(t+2<NT));     ENDW(t+1); RESC(); ROT();
  }
  STEP2(NT-1,false,false,false); RESC();
  { const int vlast=(vs_prev+VSLOT)&(NSLOTV*VSLOT-1);
    SBAR(); pv(o,vb0+vlast,PAF(0),PAF(1),PAF(2),PAF(3)); pv(o+2,vb0+vlast+8192,PAF(0),PAF(1),PAF(2),PAF(3)); }
  #undef PKW
  #undef PAF
  #undef VFR
  #undef PIN
  #undef MX3
  #undef MFM
  #undef GAPA
  #undef GAPB
  #undef GAPC
  #undef GAPS
  #undef EX
  #undef VRD
  #undef VRD2
  #undef KRD
  #undef STEP2
  #undef ENDW
  {auto rr=__builtin_amdgcn_permlane32_swap(__float_as_uint(l_reg),__float_as_uint(l_reg),false,false);l_reg=__uint_as_float(rr[0])+__uint_as_float(rr[1]);}
  if(hi==0)wsf[32+r32]=l_reg;asm volatile("s_waitcnt lgkmcnt(0)":::"memory");
  float rli[16];
  #pragma unroll
  for(int r=0;r<16;++r)rli[r]=__builtin_amdgcn_rcpf(wsf[32+crow(r,hi)]);
  bf16*Ow=O+(rowbase+q0+wid*QBLK)*PO;
  { bf16*stg=(bf16*)(shm+L2_OST)+wid*2048;
    #pragma unroll
    for(int ph=0;ph<2;++ph){
      #pragma unroll
      for(int r=0;r<16;++r){const int orow=crow(r,hi);
        #pragma unroll
        for(int d0=0;d0<2;++d0)stg[orow*64+d0*32+r32]=__float2bfloat16(o[2*ph+d0][r]*rli[r]);}
      asm volatile("s_waitcnt lgkmcnt(0)":::"memory");
      #pragma unroll
      for(int i=0;i<4;++i){const int row=i*8+(lane>>3),ch=lane&7; const u32x4 v=*(const u32x4*)(stg+row*64+ch*8); ATTN_STORE16(Ow+(long)row*PO+ph*64+ch*8,v);}
      asm volatile("s_waitcnt lgkmcnt(0)":::"memory"); } }
  asm volatile("s_waitcnt lgkmcnt(0)\n\ts_barrier":::"memory");
  #undef DMA_K
  #undef DMA_V
  #undef CMASK
  #undef CBIAS
  #undef CBIAS_ON
  #undef START
  #undef RESC
  #undef ROT
}
constexpr int ATTN_LDS_BYTES=LDS_BYTES;
#undef SBAR
#undef WAIT_BAR
}


__device__ __forceinline__ void diff_combine(bf16* P, const bf16* OS, int b, int h, int qb, float lam, const float* subg, float omli) {
    const int tid = opaque_tid(); const int row = tid >> 1, vh = tid & 1;
    asm volatile("s_waitcnt vmcnt(0)" ::: "memory"); __syncthreads();
    const size_t grow = (size_t)b * SEQ + (size_t)qb * 256 + row;
    const GAS unsigned long long* o0 = (const GAS unsigned long long*)(OS + grow * 1024 + h * 256 + vh * 64);
    const GAS unsigned long long* o1 = (const GAS unsigned long long*)(OS + grow * 1024 + h * 256 + (2 + vh) * 64);
    float y[64]; float ss = 0.f;
#pragma unroll
    for (int i = 0; i < 16; ++i) { const unsigned long long a = __hip_atomic_load(o0 + i, __ATOMIC_RELAXED, __HIP_MEMORY_SCOPE_AGENT), c = __hip_atomic_load(o1 + i, __ATOMIC_RELAXED, __HIP_MEMORY_SCOPE_AGENT);
        const unsigned a0 = (unsigned)a, a1 = (unsigned)(a >> 32), c0 = (unsigned)c, c1 = (unsigned)(c >> 32);
        y[4 * i] = bflo(a0) - lam * bflo(c0); y[4 * i + 1] = bfhi(a0) - lam * bfhi(c0); y[4 * i + 2] = bflo(a1) - lam * bflo(c1); y[4 * i + 3] = bfhi(a1) - lam * bfhi(c1);
        ss += (y[4 * i] * y[4 * i] + y[4 * i + 1] * y[4 * i + 1]) + (y[4 * i + 2] * y[4 * i + 2] + y[4 * i + 3] * y[4 * i + 3]); }
    ss += shx(ss, tid & 63, 1);
    const float rs = (1.0f / sqrtf(ss * (1.f / 128.f) + LN_EPS)) * omli;
    bf16* yp = P + grow * PP + PC_Q + h * 128 + vh * 64; const float* gp = subg + vh * 64;
#pragma unroll
    for (int i = 0; i < 8; ++i) { u32x4 w;
        w.x = pk2(y[8 * i] * rs * gp[8 * i], y[8 * i + 1] * rs * gp[8 * i + 1]); w.y = pk2(y[8 * i + 2] * rs * gp[8 * i + 2], y[8 * i + 3] * rs * gp[8 * i + 3]);
        w.z = pk2(y[8 * i + 4] * rs * gp[8 * i + 4], y[8 * i + 5] * rs * gp[8 * i + 5]); w.w = pk2(y[8 * i + 6] * rs * gp[8 * i + 6], y[8 * i + 7] * rs * gp[8 * i + 7]);
        *(u32x4*)(yp + 8 * i) = w; }
}

template <int MODE>
__device__ __forceinline__ void ln_phase(const Args& a, LAS unsigned char* lds, float* outf, const float* gam, const float* bet, const float* rw) {
    const int tid = opaque_tid(), lane = tid & 63, wave = tid >> 6;
    unsigned char* ws = a.ws;
    bf16* xb = (bf16*)(ws + WS_XB);
    int* tok_e = (int*)(ws + WS_ROUTE); int* tok_off = tok_e + 2 * M; float* tok_g = (float*)(tok_off + 2 * M);
    const bf16* fs = (const bf16*)(ws + WS_ASORT);
    gu32* cur = (gu32*)(ws + WS_CTL) + CW_CUR;
    LAS int* lcnt = (LAS int*)lds;
    LAS int* lbase = lcnt + 8;
    LAS int* lrow = lcnt + 16;
    if (MODE == 1) { if (tid < 16) lcnt[tid] = 0; __syncthreads(); }
    f32x4 gv[4], bv[4];
#pragma unroll
    for (int q = 0; q < 4; ++q) { gv[q] = *(const f32x4*)(gam + 8 * lane + 512 * (q >> 1) + 4 * (q & 1)); bv[q] = *(const f32x4*)(bet + 8 * lane + 512 * (q >> 1) + 4 * (q & 1)); }
    LAS f32x4* rwlA = (LAS f32x4*)(lds + 4096);
    LAS f32x4* rwlB = rwlA + 1024;

    f32x4 rwr[16][2];
    if (MODE == 1) {
#pragma unroll
        for (int q = 0; q < 4; ++q)
#pragma unroll
            for (int i = 0; i < 4; ++i) { const int col = 8 * lane + 512 * (q >> 1) + 4 * (q & 1) + i; rwr[q * 4 + i][0] = *((const f32x4*)rw + 2 * col); rwr[q * 4 + i][1] = *((const f32x4*)rw + 2 * col + 1); } }
    const int row0 = pair_row0(opaque_s((int)blockIdx.x)); const int rowbase = row0 + wave * 16;
    u32x4 nz[4][2], nw1[4][2], nw2[4][2]; float ng1[4], ng2[4];
    int mypos = 0; float myg = 0.f;
    if (MODE == 2) {
        const int ee = tok_e[2 * rowbase + (lane & 31)], oo = tok_off[2 * rowbase + (lane & 31)]; myg = tok_g[2 * rowbase + (lane & 31)];
        int acc = 0, sb = 0;
#pragma unroll
        for (int e = 0; e < 8; ++e) { sb = (ee == e) ? acc : sb; acc += ((int)__hip_atomic_load(cur + 64 * e, __ATOMIC_RELAXED, __HIP_MEMORY_SCOPE_AGENT) + 255) & ~255; }
        mypos = sb + oo; }
#define LN_LOAD(SL, RR) do { const int rr_ = (RR); const int row_ = rowbase + rr_; const u32x4* zr_ = (const u32x4*)(xb + (size_t)row_ * DM) + lane; \
        if (MODE == 2) { nz[SL][0] = __builtin_nontemporal_load(zr_); nz[SL][1] = __builtin_nontemporal_load(zr_ + 64); } else { nz[SL][0] = zr_[0]; nz[SL][1] = zr_[64]; }     \
        if (MODE == 2) { const int p1 = __builtin_amdgcn_readlane(mypos, 2 * rr_), p2 = __builtin_amdgcn_readlane(mypos, 2 * rr_ + 1); \
            ng1[SL] = __builtin_bit_cast(float, __builtin_amdgcn_readlane(__builtin_bit_cast(int, myg), 2 * rr_)); ng2[SL] = __builtin_bit_cast(float, __builtin_amdgcn_readlane(__builtin_bit_cast(int, myg), 2 * rr_ + 1)); \
            const u32x4* f1 = (const u32x4*)(fs + (size_t)p1 * DM) + lane; const u32x4* f2 = (const u32x4*)(fs + (size_t)p2 * DM) + lane; \
            nw1[SL][0] = __builtin_nontemporal_load(f1); nw1[SL][1] = __builtin_nontemporal_load(f1 + 64); nw2[SL][0] = __builtin_nontemporal_load(f2); nw2[SL][1] = __builtin_nontemporal_load(f2 + 64); } } while (0)
#define LN_UNPK_LO(W_) ((f32x4){bflo((W_).x), bfhi((W_).x), bflo((W_).y), bfhi((W_).y)})
#define LN_UNPK_HI(W_) ((f32x4){bflo((W_).z), bfhi((W_).z), bflo((W_).w), bfhi((W_).w)})
    LN_LOAD(0, 0); LN_LOAD(1, 1); LN_LOAD(2, 2);
#pragma unroll 1
    for (int rq = 0; rq < 16; rq += 4) {
#pragma unroll
      for (int u = 0; u < 4; ++u) {
        const int rr = rq + u;
        const int row = rowbase + rr;
        if (rr + 3 < 16) LN_LOAD((u + 3) & 3, rr + 3);
        f32x4 v[4]; float s = 0.f;
#pragma unroll
        for (int j = 0; j < 2; ++j) { v[2 * j] = LN_UNPK_LO(nz[u][j]); v[2 * j + 1] = LN_UNPK_HI(nz[u][j]); }
        if (MODE == 2) {
#pragma unroll
            for (int j = 0; j < 2; ++j) { const u32x4 w1 = nw1[u][j], w2 = nw2[u][j];
                v[2 * j] = v[2 * j] * ALPHA + LN_UNPK_LO(w1) * ng1[u] + LN_UNPK_LO(w2) * ng2[u];
                v[2 * j + 1] = v[2 * j + 1] * ALPHA + LN_UNPK_HI(w1) * ng1[u] + LN_UNPK_HI(w2) * ng2[u]; }
        }
#pragma unroll
        for (int j = 0; j < 4; ++j) s += (v[j].x + v[j].y) + (v[j].z + v[j].w);
        const float mean = wave_sum(s, lane) * (1.f / DM); float s2 = 0.f;
#pragma unroll
        for (int j = 0; j < 4; ++j) { v[j] = v[j] - mean; s2 += (v[j].x * v[j].x + v[j].y * v[j].y) + (v[j].z * v[j].z + v[j].w * v[j].w); }
        const float rstd = 1.f / sqrtf(wave_sum(s2, lane) * (1.f / DM) + LN_EPS);
#pragma unroll
        for (int j = 0; j < 4; ++j) v[j] = v[j] * rstd * gv[j] + bv[j];
        if (MODE != 2) { u32x4* o = (u32x4*)(xb + (size_t)row * DM) + lane; o[0] = pack8(v[0], v[1]); o[64] = pack8(v[2], v[3]); }
        else { f32x4* of = (f32x4*)(outf + (size_t)row * DM + 8 * lane); __builtin_nontemporal_store(v[0], of); __builtin_nontemporal_store(v[1], of + 1); __builtin_nontemporal_store(v[2], of + 128); __builtin_nontemporal_store(v[3], of + 129); }
        if (MODE == 1) {
            float lg[8];
#pragma unroll
            for (int e = 0; e < 8; ++e) lg[e] = 0.f;
#pragma unroll
            for (int q = 0; q < 4; ++q)
#pragma unroll
                for (int i = 0; i < 4; ++i) { const float xv = v[q][i]; const f32x4 r0 = rwr[q * 4 + i][0], r1 = rwr[q * 4 + i][1];
                    lg[0] += xv * r0.x; lg[1] += xv * r0.y; lg[2] += xv * r0.z; lg[3] += xv * r0.w;
                    lg[4] += xv * r1.x; lg[5] += xv * r1.y; lg[6] += xv * r1.z; lg[7] += xv * r1.w; }
#pragma unroll
            for (int e = 0; e < 8; ++e) lg[e] = wave_sum(lg[e], lane);
            int i1 = 0; float v1 = lg[0];
#pragma unroll
            for (int e = 1; e < 8; ++e) if (lg[e] > v1) { v1 = lg[e]; i1 = e; }
            int i2 = -1; float v2 = -INFINITY;
#pragma unroll
            for (int e = 0; e < 8; ++e) if (e != i1 && lg[e] > v2) { v2 = lg[e]; i2 = e; }
            const float ex = __expf(v2 - v1); const float w1 = 1.0f / (1.0f + ex), w2 = ex * w1;
            if (lane == 0) {
                const int k1 = atomicAdd((int*)&lcnt[i1], 1), k2 = atomicAdd((int*)&lcnt[i2], 1);
                lrow[(wave * 16 + rr) * 4 + 0] = i1; lrow[(wave * 16 + rr) * 4 + 1] = i2; lrow[(wave * 16 + rr) * 4 + 2] = k1; lrow[(wave * 16 + rr) * 4 + 3] = k2;
                tok_g[2 * row] = w1; tok_g[2 * row + 1] = w2;
            }
        }
      }
    }
    if (MODE == 1) { asm volatile("s_waitcnt vmcnt(0)" ::: "memory");
#pragma unroll 4
        for (int rr = 0; rr < 16; ++rr) { const int row = rowbase + rr; const u32x4* src = (const u32x4*)(xb + (size_t)row * DM) + lane; u32x2* o8 = (u32x2*)(ws + WS_XB8 + (size_t)row * DM) + lane;
#pragma unroll
            for (int j = 0; j < 2; ++j) { const u32x4 w = src[64 * j];
                o8[64 * j] = (u32x2){pk4f8(bflo(w.x) * F8_SC_Y, bfhi(w.x) * F8_SC_Y, bflo(w.y) * F8_SC_Y, bfhi(w.y) * F8_SC_Y), pk4f8(bflo(w.z) * F8_SC_Y, bfhi(w.z) * F8_SC_Y, bflo(w.w) * F8_SC_Y, bfhi(w.w) * F8_SC_Y)}; } } }
#undef LN_LOAD
#undef LN_UNPK_LO
#undef LN_UNPK_HI
    if (MODE == 1) {
        __syncthreads();
        if (tid < 8) lbase[tid] = (int)__hip_atomic_fetch_add(cur + 64 * tid, (unsigned)lcnt[tid], __ATOMIC_RELAXED, __HIP_MEMORY_SCOPE_AGENT);
        __syncthreads();
        if (tid < 128) { const int row = row0 + tid; const int e1 = lrow[tid * 4], e2 = lrow[tid * 4 + 1];
            const int o1 = lbase[e1] + lrow[tid * 4 + 2], o2 = lbase[e2] + lrow[tid * 4 + 3];
            tok_e[2 * row] = e1; tok_e[2 * row + 1] = e2; tok_off[2 * row] = o1; tok_off[2 * row + 1] = o2;
            int* rowtok = (int*)(ws + WS_ROWTOK); rowtok[e1 * 32768 + o1] = row; rowtok[e2 * 32768 + o2] = row; }
        __syncthreads();
    }
}

template <int l> __device__ __forceinline__ void layer_body(const Args& args, LAS unsigned char* lds, unsigned char* lds_raw, const XcdBarrier& bar) {
#define GRID_BAR() xcd_barrier(bar)
        {   unsigned char* ws = opq(args.ws); const int blk = opaque_s((int)blockIdx.x), G = opaque_s((int)gridDim.x);
            Gemm g{(const bf16*)(ws + WS_XB), (const bf16*)(ws + WS_WIN) + (size_t)l * DIN * DM, DM, DM};
            EpiInProj E{(bf16*)(ws + WS_P)};
            if (l == 0) { StaticOrder S; S.init(M, DIN, G, blk); GEMM_PHASE(lds, g, S, E); }
            else {
                pair_sync((unsigned*)((gu32*)(ws + WS_CTL) + CW_PAIR) + 16 * (3 * 128 + 2 * 64 + quad_id(blk)), bar, 4u);
                QuadOrder S; S.c = blk; S.nn = DIN / 256; GEMM_PHASE(lds, g, S, E); }
        }
        GRID_BAR();
        {
            unsigned char* ws = opq(args.ws); const int blk = opaque_s((int)blockIdx.x), G = opaque_s((int)gridDim.x);
            bf16* P = (bf16*)(ws + WS_P);
            const float lam_init = (l == 0) ? 0.2f : (0.8f - 0.6f * 0.7408182206817179f);
            float lam;
            LAS float* btab = (LAS float*)(lds + RING_BYTES - 2048);
            LAS float* xtab = (LAS float*)(lds + RING_BYTES - 6144);
            {   const int tid = opaque_tid(), lane = tid & 63;
                const float* q1 = args.in[I_LQ1] + l * 64; const float* k1 = args.in[I_LK1] + l * 64; const float* q2 = args.in[I_LQ2] + l * 64; const float* k2 = args.in[I_LK2] + l * 64;
                const float d1 = wave_sum(q1[lane] * k1[lane], lane), d2 = wave_sum(q2[lane] * k2[lane], lane);
                lam = __builtin_bit_cast(float, __builtin_amdgcn_readfirstlane(__builtin_bit_cast(int, __expf(d1) - __expf(d2) + lam_init)));
                __syncthreads();
                const int hh = tid >> 7, d = tid & 127; const float* rb = args.in[I_RELB];
                btab[hh * 128 + d] = (rb[t5_bucket(d) * 4 + hh] - rb[31 * 4 + hh]) * LOG2E;
                __syncthreads();
                {   const int vcu_ = (blk & 7) * (G >> 3) + (blk >> 3); const int h_ = (vcu_ >> 5) & 3;
                    for (int i = tid; i < 640; i += NTHR) { const int dist = i - 256; xtab[i] = (dist >= 0 && dist < 128) ? btab[h_ * 128 + dist] : 0.f; } }
                __syncthreads(); }
#ifdef USE_NAIVE_ATTN
            for (int i = 0; i < 8; ++i) {
                const int L = i * G + blk; const int bh = L & 7, qt = L >> 3;
                nattn_unit(lds, P, bh >> 2, bh & 3, qt, btab + (bh & 3) * 128, lam, args.in[I_SUBG] + l * 128, 1.0f - lam_init);
            }
#else
            {
                const int vcu = (blk & 7) * (G >> 3) + (blk >> 3); const int bh = vcu >> 5, sp = vcu & 31, b = bh >> 2, h = bh & 3;
                bf16* OS = (bf16*)(ws + WS_OSCR);
#pragma unroll 1
                for (int u4 = 0; u4 < 4; ++u4) {
                    const int m = u4 >> 1; const int qb = (u4 & 1) ? sp : 63 - sp;
                    attn_body::attn_unit2<8>(b, qb, (const attn_body::bf16*)(P + PC_Q + h * 128 + m * 64), (const attn_body::bf16*)(P + PC_K + h * 128 + m * 64),
                                             (const attn_body::bf16*)(P + PC_VA + h * 128), (attn_body::bf16*)(OS + h * 256 + m * 128), xtab, (char*)lds_raw);
                    if (u4 >= 2) diff_combine(P, OS, b, h, qb, lam, args.in[I_SUBG] + l * 128, 1.0f - lam_init);
                }
                __syncthreads();
            }
#endif
            chunk_unit(lds, P, blk, (const bf16*)(ws + WS_WB) + (size_t)l * 4 * 128 * 128, args.in[I_GBS] + l * 512, (const bf16*)(ws + WS_PWT) + (size_t)l * 4 * 64 * 64, args.in[I_POOLS] + l * 256);
        }
        GRID_BAR();
        {   unsigned char* ws = opq(args.ws); const int blk = opaque_s((int)blockIdx.x), G = opaque_s((int)gridDim.x);
            Gemm g{(const bf16*)(ws + WS_P), (const bf16*)(ws + WS_WOUT) + (size_t)l * DM * DM, PP, DM};
            PairOrder S; S.c = blk;
            EpiResid E{(bf16*)(ws + WS_XB)};
            GEMM_PHASE(lds, g, S, E);
            pair_sync((unsigned*)((gu32*)(ws + WS_CTL) + CW_PAIR) + 16 * ((l * 2) * 128 + pair_panel(blk)), bar);
        }
        if (l == 0) ln_phase<0>(args, lds, opq(args.out), args.in[I_LN1G] + l * DM, args.in[I_LN1B] + l * DM, nullptr);
        else ln_phase<1>(args, lds, opq(args.out), args.in[I_LN1G] + l * DM, args.in[I_LN1B] + l * DM, args.in[I_RW]);
        if (l == 0) {
            {   unsigned char* ws = opq(args.ws); const int blk = opaque_s((int)blockIdx.x);
                unsigned* qw = (unsigned*)((gu32*)(ws + WS_CTL) + CW_PAIR) + 16 * (3 * 128 + quad_id(blk));
                pair_sync(qw, bar, 4u);
                Gemm g{(const bf16*)(ws + WS_XB), (const bf16*)(ws + WS_W13), DM, DM};
                QuadOrder S; S.c = blk; S.nn = 22;
                EpiSwiglu8 E{(unsigned char*)(ws + WS_HID), DFF};
                GEMM_PHASE(lds, g, S, E);
                pair_sync(qw + 16 * 64, bar, 4u);
            }
            {   unsigned char* ws = opq(args.ws); const int blk = opaque_s((int)blockIdx.x), G = opaque_s((int)gridDim.x);
                Gemm g{(const bf16*)(ws + WS_HID), (const bf16*)(ws + WS_W2), DFF, DFF, F8_E8_H, F8_E8_W};
                PairOrder S; S.c = blk;
                EpiResid E{(bf16*)(ws + WS_XB)};
                pg8::gemm_phase<EpiResid, PairOrder, false, false, true>(lds, g, S, E);
                pair_sync((unsigned*)((gu32*)(ws + WS_CTL) + CW_PAIR) + 16 * (1 * 128 + pair_panel(blk)), bar);
            }
            ln_phase<0>(args, lds, opq(args.out), args.in[I_LN2G] + l * DM, args.in[I_LN2B] + l * DM, nullptr);
        } else {
            GRID_BAR();
            unsigned char* ws = opq(args.ws); const int blk = opaque_s((int)blockIdx.x), G = opaque_s((int)gridDim.x);
            gu32* ctl = (gu32*)(ws + WS_CTL);
            bf16* asort = (bf16*)(ws + WS_ASORT); const bf16* xb = (const bf16*)(ws + WS_XB);
            int seg[9]; seg[0] = 0;
#pragma unroll
            for (int e = 0; e < 8; ++e) { const int cnt = __builtin_amdgcn_readfirstlane((int)__hip_atomic_load(ctl + CW_CUR + 64 * e, __ATOMIC_RELAXED, __HIP_MEMORY_SCOPE_AGENT)); seg[e + 1] = seg[e] + ((cnt + 255) & ~255); }
            const int ntot = seg[8] >> 8;
            MoeOrder S; S.ts1 = seg[1] >> 8; S.ts2 = seg[2] >> 8; S.ts3 = seg[3] >> 8; S.ts4 = seg[4] >> 8; S.ts5 = seg[5] >> 8; S.ts6 = seg[6] >> 8; S.ts7 = seg[7] >> 8; S.G = G; S.c = blk; S.rowtok = (const int*)(ws + WS_ROWTOK);
            const int nf = ntot >> 7, nr = ntot & 127, ns = nf + (nr > 0 ? 1 : 0);
            bf16* hbuf0 = (bf16*)opq(args.out); bf16* hbuf1 = (bf16*)(ws + WS_HCH);
            for (int j = 0; j <= ns; ++j) {
                if (j >= 1) {
                    const int jj = j - 1; const bool rem = (nr > 0 && jj == 0); const int k = jj - (nr > 0 ? 1 : 0);
                    S.c0 = rem ? nf * 128 : k * 128; S.ntc = rem ? nr : 128; S.ncol = 4; S.up = false; S.skipn = 0;
                    Gemm g{(jj & 1) ? hbuf1 : hbuf0, (const bf16*)(ws + WS_MW2), DFE, DFE, F8_E8_H, F8_E8_W};
                    EpiPlain E{asort, DM};
                    pg8::gemm_phase<EpiPlain, MoeOrder, false, false, true>(lds, g, S, E);
                }
                if (j < ns) {
                    const bool rem = (nr > 0 && j == 0); const int k = j - (nr > 0 ? 1 : 0);
                    const int ndown = (j >= 1) ? S.ntc * 4 : 0;
                    S.c0 = rem ? nf * 128 : k * 128; S.ntc = rem ? nr : 128; S.ncol = 28; S.up = true; S.skipn = (ndown > 0 && ndown < G) ? ndown : 0;
                    Gemm g{(const bf16*)(ws + WS_XB8), (const bf16*)(ws + WS_MW13), DM, DM, F8_E8_Y, F8_E8_W};
                    EpiSwiglu8 E{(unsigned char*)((j & 1) ? hbuf1 : hbuf0), DFE};
                    pg8::gemm_phase<EpiSwiglu8, MoeOrder, true, false, true>(lds, g, S, E);
                }
                GRID_BAR();
            }
            ln_phase<2>(args, lds, opq(args.out), args.in[I_LN2G] + l * DM, args.in[I_LN2B] + l * DM, nullptr);
        }
#undef GRID_BAR
}

__global__ void __launch_bounds__(NTHR, 2) fwd_kernel(Args args) {
    extern __shared__ __attribute__((aligned(16))) unsigned char lds_raw[];
    LAS unsigned char* lds = (LAS unsigned char*)lds_raw;
    {   const int tid = threadIdx.x;
        for (int u = tid; u < (LDS_BYTES - LDSCTL_OFF) / 4; u += NTHR) ((LAS unsigned*)(lds + LDSCTL_OFF))[u] = 0u;
        __syncthreads(); }
    XcdBarrier bar = xcd_barrier_post((unsigned*)((gu32*)(args.ws + WS_CTL) + CW_BAR), (volatile LAS unsigned*)(lds + MISC_OFF) + 8);
#define GRID_BAR() xcd_barrier(bar)

    {   const int tid = opaque_tid(), lane = tid & 63, wave = __builtin_amdgcn_readfirstlane(tid >> 6);
        prologue(args, lds, (int)blockIdx.x * NWAVES + wave, (int)gridDim.x * NWAVES, wave, lane); }
    {   const int blk = opaque_s((int)blockIdx.x); unsigned* xw = bar.bar + opaque0() - CW_BAR + CW_XCC + blk;
        if (opaque_tid() == 0) (void)xb_add(xw, bar.x + 1u); }
    GRID_BAR();

    layer_body<0>(args, lds, lds_raw, bar);
    layer_body<1>(args, lds, lds_raw, bar);
#undef GRID_BAR
}

extern "C" void kernel_launch(void* const* d_in, const int* in_sizes, int n_in, void* d_out, int out_size, void* d_ws, size_t ws_size, hipStream_t stream) {
    static int ready = 0;
    if (ready == 0) {
        if (n_in != 24 || in_sizes[0] != M * DM || out_size != M * DM || ws_size < WS_END) { fprintf(stderr, "kernel_launch: unexpected shapes (n_in %d, in0 %d, out %d, ws %zu)\n", n_in, n_in > 0 ? in_sizes[0] : -1, out_size, ws_size); ready = -1; return; }
        if (hipFuncSetAttribute((const void*)fwd_kernel, hipFuncAttributeMaxDynamicSharedMemorySize, LDS_BYTES) != hipSuccess) { fprintf(stderr, "kernel_launch: hipFuncSetAttribute failed\n"); ready = -1; return; }
        int per_cu = 0;
        if (hipOccupancyMaxActiveBlocksPerMultiprocessor(&per_cu, (const void*)fwd_kernel, NTHR, LDS_BYTES) != hipSuccess || per_cu < 1) fprintf(stderr, "kernel_launch: occupancy query says %d\n", per_cu);
        (void)hipGetLastError();
        ready = 1;
    }
    if (ready < 0) return;
    (void)hipMemsetAsync((char*)d_ws + WS_CTL, 0, CTL_ZERO_BYTES, stream);
    Args a{};
    for (int i = 0; i < 24; ++i) a.in[i] = (const float*)d_in[i];
    a.out = (float*)d_out; a.ws = (unsigned char*)d_ws;
    hipLaunchKernelGGL(fwd_kernel, dim3(GRID), dim3(NTHR), LDS_BYTES, stream, a);
}
```

```cpp
#include <hip/hip_runtime.h>
#include <cstdio>
#include <cstdint>

#define GAS __attribute__((address_space(1)))
#define LAS __attribute__((address_space(3)))
typedef unsigned short bf16;
typedef unsigned u32x4 __attribute__((ext_vector_type(4)));
typedef unsigned u32x2 __attribute__((ext_vector_type(2)));
typedef float f32x4 __attribute__((ext_vector_type(4)));
typedef float f32x2 __attribute__((ext_vector_type(2)));
typedef GAS unsigned gu32;

constexpr int BATCH = 2, SEQ = 16384, DM = 1024, M = BATCH * SEQ, DIN = 2304, DFF = 2816, NEXP = 8, DFE = 3584, DEPTH = 2;
constexpr float LN_EPS = 1e-5f;
constexpr float ALPHA = 1.4142135623730951f;
constexpr float LOG2E = 1.4426950408889634f;
constexpr float C2 = 0.125f * LOG2E;
constexpr int NWAVES = 8, NTHR = 512, GRID = 256;
constexpr int PP = DIN;
constexpr int PC_U = 0, PC_V = 256, PC_Q = 512, PC_K = 1024, PC_VA = 1536, PC_C = 2048;

constexpr size_t MiB = 1u << 20;
constexpr size_t WS_CTL = 0, CTL_ZERO_BYTES = 1 * MiB;
constexpr size_t WS_WB = 1 * MiB;
constexpr size_t WS_PWT = 1 * MiB + 256 * 1024;
constexpr size_t WS_ROUTE = 2 * MiB;
constexpr size_t WS_WIN = 4 * MiB;
constexpr size_t WS_WOUT = 13 * MiB;
constexpr size_t WS_W13 = 17 * MiB;
constexpr size_t WS_W2 = 28 * MiB;
constexpr size_t WS_MW13 = 34 * MiB;
constexpr size_t WS_MW2 = 146 * MiB;
constexpr size_t WS_XB = 202 * MiB;
constexpr size_t WS_BIG = 266 * MiB;
constexpr size_t WS_P = WS_BIG;
constexpr size_t WS_OSCR = WS_BIG + 144 * MiB;
constexpr size_t WS_HID = WS_BIG + 144 * MiB;
constexpr size_t WS_ASORT = WS_BIG;
constexpr size_t WS_HCH = WS_BIG + 132 * MiB;
constexpr size_t WS_XB8 = 96 * MiB;
constexpr size_t WS_ROWTOK = 510 * MiB;
constexpr size_t WS_END = 520 * MiB;
constexpr int CHUNK_TILES = 64;
constexpr int MAX_RT = 264;

constexpr int CW_BAR = 4096;
constexpr int CW_CUR = 16384;
constexpr int CW_XCC = 49152;
constexpr int CW_PAIR = 32768;

constexpr int RING_BYTES = 131072;
constexpr int LDSCTL_OFF = RING_BYTES, MISC_OFF = LDSCTL_OFF + 320;
constexpr int LDS_BYTES = 147456;

__device__ __forceinline__ unsigned f2bf(float f) { unsigned u = __builtin_bit_cast(unsigned, f); return (u + 0x7fffu + ((u >> 16) & 1u)) >> 16; }
__device__ __forceinline__ unsigned pk2(float lo, float hi) { return f2bf(lo) | (f2bf(hi) << 16); }
__device__ __forceinline__ float bflo(unsigned w) { return __builtin_bit_cast(float, w << 16); }
__device__ __forceinline__ float bfhi(unsigned w) { return __builtin_bit_cast(float, w & 0xffff0000u); }
__device__ __forceinline__ u32x2 pack4(f32x4 v) { u32x2 r; r.x = pk2(v.x, v.y); r.y = pk2(v.z, v.w); return r; }
__device__ __forceinline__ size_t opaque0() { unsigned z = 0u; asm volatile("" : "+s"(z)); return (size_t)z; }
__device__ __forceinline__ int opaque_tid() { int t = threadIdx.x; asm volatile("" : "+v"(t)); return t; }
__device__ __forceinline__ int opaque_s(int x) { asm volatile("" : "+s"(x)); return x; }
#define opq(p) ((p) + opaque0())
__device__ __forceinline__ float shx(float v, int lane, int o) { return __builtin_bit_cast(float, __builtin_amdgcn_ds_bpermute((lane ^ o) << 2, __builtin_bit_cast(int, v))); }
__device__ __forceinline__ float wave_sum(float v, int lane) {
#pragma unroll
    for (int o = 1; o < 64; o <<= 1) v += __builtin_bit_cast(float, __builtin_amdgcn_ds_bpermute((lane ^ o) << 2, __builtin_bit_cast(int, v)));
    return v;
}
__device__ __forceinline__ float gelu1(float v) {
    const float av = __builtin_fabsf(v), d = av * 0.2316418882f + 1.0f;
    const float t = __builtin_amdgcn_rcpf(d);
    float q = t * 0.5307027145f + (-0.7265760135f); q = q * t + 0.7107068705f; q = q * t + (-0.142248368f); q = q * t + 0.127414796f; q = q * t;
    const float s = (v * v) * (-0.72134752044f);
    const float e = __builtin_amdgcn_exp2f(s);
    const float m = v * (q * e), r = v - m;
    return v < 0.f ? m : r;
}
__device__ __forceinline__ f32x4 gelu4(f32x4 v) { f32x4 o; o.x = gelu1(v.x); o.y = gelu1(v.y); o.z = gelu1(v.z); o.w = gelu1(v.w); return o; }
__device__ __forceinline__ float silu1(float a) { return a * __builtin_amdgcn_rcpf(1.0f + __builtin_amdgcn_exp2f(-a * LOG2E)); }

#define XB_TMO      128
#define XB_XCNT(j)  (256  + 64 * (j))
#define XB_XSUB(j)  (1280 + 64 * (j))
#define XB_XGEN(j)  (2304 + 64 * (j))
#define XB_TOP      3328
#define XB_TOPGEN   3392
#define XCD_BAR_WORDS 3456
#define XB_SPIN_CAP (1u << 22)

__device__ __forceinline__ unsigned xb_ld(unsigned* p)              { return __hip_atomic_load(p, __ATOMIC_RELAXED, __HIP_MEMORY_SCOPE_AGENT); }
__device__ __forceinline__ unsigned xb_add(unsigned* p, unsigned v) { return __hip_atomic_fetch_add(p, v, __ATOMIC_RELAXED, __HIP_MEMORY_SCOPE_AGENT); }
__device__ __forceinline__ unsigned xb_xcc_id() { return (unsigned)__builtin_amdgcn_s_getreg((3 << 11) | 20) & 0xFu; }
#define XB_SPIN(cond, bar) do { unsigned _sp = 0; while (cond) { __builtin_amdgcn_s_sleep(1); \
    if ((++_sp & 255u) == 0u) { if (xb_ld(&(bar)[XB_TMO])) break; if (_sp > XB_SPIN_CAP) { atomicAdd(&(bar)[XB_TMO], 1u); break; } } } } while (0)

struct XcdBarrier { unsigned* bar; unsigned x; volatile LAS unsigned* st; };

__device__ __forceinline__ XcdBarrier xcd_barrier_post(unsigned* bar, volatile LAS unsigned* st) {
    XcdBarrier b; b.bar = bar; b.x = xb_xcc_id(); b.st = st;
    if (threadIdx.x == 0) (void)xb_add(&bar[XB_XCNT(b.x)], 1u);
    return b;
}
__device__ __forceinline__ void xcd_barrier_complete(unsigned* bar, unsigned x, unsigned& nloc, unsigned& nx) {
    const unsigned G = gridDim.x * gridDim.y * gridDim.z;
    unsigned sum, cnt, mine, sp = 0u;
    for (;;) {
        sum = 0u; cnt = 0u; mine = 0u;
#pragma unroll
        for (unsigned j = 0; j < 16; ++j) { const unsigned c = xb_ld(&bar[XB_XCNT(j)]); sum += c; cnt += (c > 0u) ? 1u : 0u; mine = (j == x) ? c : mine; }
        if (sum == G) break;
        __builtin_amdgcn_s_sleep(1);
        if ((++sp & 255u) == 0u) { if (xb_ld(&bar[XB_TMO])) break; if (sp > XB_SPIN_CAP) { atomicAdd(&bar[XB_TMO], 1u); break; } }
    }
    nloc = mine > 0u ? mine : 1u; nx = cnt > 0u ? cnt : 1u;
}
__device__ __forceinline__ void xcd_barrier(const XcdBarrier& b) {
    asm volatile("s_waitcnt vmcnt(0)" ::: "memory");
    __syncthreads();
    if (threadIdx.x == 0) {
        unsigned* bar = b.bar + opaque0();
        __builtin_amdgcn_s_waitcnt(0);
        unsigned nloc = b.st[0], nx = b.st[1];
        if (nloc == 0u) { xcd_barrier_complete(bar, b.x, nloc, nx); b.st[0] = nloc; b.st[1] = nx; }
        const unsigned old = xb_add(&bar[XB_XSUB(b.x)], 1u);
        const unsigned gen = old / nloc;
        if (old + 1u == (gen + 1u) * nloc) {
            __builtin_amdgcn_fence(__ATOMIC_RELEASE, "agent");
            asm volatile("s_waitcnt vmcnt(0)" ::: "memory");
            const unsigned og = xb_add(&bar[XB_TOP], 1u);
            const unsigned tg = og / nx;
            if (og + 1u == (tg + 1u) * nx) xb_add(&bar[XB_TOPGEN], 1u);
            else XB_SPIN(xb_ld(&bar[XB_TOPGEN]) == tg, bar);
            __builtin_amdgcn_fence(__ATOMIC_ACQUIRE, "agent");
            xb_add(&bar[XB_XGEN(b.x)], 1u);
            asm volatile("s_waitcnt vmcnt(0)" ::: "memory");
        } else {
            XB_SPIN(xb_ld(&bar[XB_XGEN(b.x)]) == gen, bar);
            __builtin_amdgcn_fence(__ATOMIC_ACQUIRE, "agent");
            asm volatile("s_waitcnt vmcnt(0)" ::: "memory");
        }
    }
    __syncthreads();
}

__device__ __forceinline__ void pair_sync(unsigned* w, const XcdBarrier& b, unsigned n = 2u) {
    asm volatile("s_waitcnt vmcnt(0)" ::: "memory");
    __syncthreads();
    if (threadIdx.x == 0) {
        unsigned* bar = b.bar + opaque0();
        bool same = true;
        for (unsigned j = 1; j < n; ++j) same = same && ((unsigned)__builtin_amdgcn_readfirstlane((int)xb_ld(bar - CW_BAR + CW_XCC + (blockIdx.x ^ (8u * j)))) == b.x + 1u);
        if (!same) { __builtin_amdgcn_fence(__ATOMIC_RELEASE, "agent"); asm volatile("s_waitcnt vmcnt(0)" ::: "memory"); }
        (void)xb_add(w, 1u);
        XB_SPIN(xb_ld(w) < n, bar);
        __builtin_amdgcn_fence(__ATOMIC_ACQUIRE, "agent");
        asm volatile("s_waitcnt vmcnt(0)" ::: "memory");
    }
    __syncthreads();
}
__device__ __forceinline__ int pair_panel(int c) { return (c & 7) * 16 + (c >> 4); }
__device__ __forceinline__ int pair_row0(int c) { return pair_panel(c) * 256 + ((c >> 3) & 1) * 128; }

struct Unit { int pm, pn, om, on, ge, gl; };
struct Gemm { const bf16* A; const bf16* Bt; int lda, K; int sa = 0, sb = 0; };

constexpr int NXCD = 8, WGM = 8;
struct StaticOrder {
    int nM, nN, nwg, G, c;
    __device__ __forceinline__ void init(int M_, int N_, int G_, int c_) { nM = M_ / 256; nN = N_ / 256; nwg = nM * nN; G = G_; c = c_; }
    __device__ __forceinline__ bool next(int i, Unit& u) const {
        long L = (long)i * G + c;
        {   const int full = nwg / G, part = nwg - full * G;
            if (i == full && part > 0) { if (c < G - part) return false; L = (long)i * G + (c - (G - part)); } }
        if (L >= nwg) return false;
        int wgid = (int)L; { const int q = nwg / NXCD, r = nwg % NXCD, xcd = wgid % NXCD, off = wgid / NXCD; wgid = (xcd < r ? xcd * (q + 1) : r * (q + 1) + (xcd - r) * q) + off; }
        const int nig = WGM * nN, gid = wgid / nig, fm = gid * WGM, gsz = (nM - fm) < WGM ? (nM - fm) : WGM;
        u.pm = fm + ((wgid % nig) % gsz); u.pn = (wgid % nig) / gsz; u.om = u.pm; u.on = u.pn; return true;
    }
    __device__ __forceinline__ void a_ready(const Unit&) const {}
    __device__ __forceinline__ void done(const Unit&) const {}
};
struct PairOrder {
    int c;
    __device__ __forceinline__ bool next(int i, Unit& u) const { if (i >= 2) return false; u.pm = pair_panel(c); u.pn = ((c >> 3) & 1) * 2 + i; u.om = u.pm; u.on = u.pn; return true; }
    __device__ __forceinline__ void a_ready(const Unit&) const {}
    __device__ __forceinline__ void done(const Unit&) const {}
};
struct QuadOrder {
    int c, nn;
    __device__ __forceinline__ bool next(int i, Unit& u) const { const int uu = i * 4 + ((c >> 3) & 3), hi = uu >= nn ? 1 : 0; if (uu >= 2 * nn) return false;
        int pn = uu - nn * hi;
        if (nn == 9 && pn < 4) pn = hi ? ((0x3102 >> (4 * pn)) & 3) : (pn ^ 2);
        u.pm = (c & 7) * 16 + (c >> 5) * 2 + hi; u.pn = pn; u.om = u.pm; u.on = u.pn; return true; }
    __device__ __forceinline__ void a_ready(const Unit&) const {}
    __device__ __forceinline__ void done(const Unit&) const {}
};
__device__ __forceinline__ int quad_id(int c) { return (c & 7) * 8 + (c >> 5); }
struct MoeOrder {
    int ts1, ts2, ts3, ts4, ts5, ts6, ts7;
    const int* rowtok;
    int c0, ntc, ncol, G, c, skipn; bool up;
    __device__ __forceinline__ bool next(int i, Unit& u) const {
        if (up && ntc == 128 && G == 256) {
            const int D = skipn, x = (D > 0) ? (3584 - (7 * (256 - D)) / 2 + 128) / 256 : 14, nx = 14 - x;
            int oc = c, oi = i;
            if (c < D) { if (i >= x) return false; }
            else if (i >= 14) { const int o = (c - D) + (i - 14) * (256 - D); if (nx == 0 || o >= D * nx) return false; oc = o / nx; oi = x + o % nx; }
            const int li = oc >> 3, rtl = (oc & 7) * 16 + (li >> 1), pn = (li & 1) * 14 + oi, rt = c0 + rtl;
            const int e = (rt >= ts1) + (rt >= ts2) + (rt >= ts3) + (rt >= ts4) + (rt >= ts5) + (rt >= ts6) + (rt >= ts7);
            int tse = 0; tse = (e == 1) ? ts1 : tse; tse = (e == 2) ? ts2 : tse; tse = (e == 3) ? ts3 : tse; tse = (e == 4) ? ts4 : tse; tse = (e == 5) ? ts5 : tse; tse = (e == 6) ? ts6 : tse; tse = (e == 7) ? ts7 : tse;
            u.pn = e * ncol + pn; u.on = pn; u.pm = rt; u.om = rtl; u.ge = e; u.gl = rt - tse; return true; }
        if (!up && ntc == 128 && G == 256) {
            if (i >= 2) return false;
            const int li = c >> 3, rtl = (c & 7) * 16 + (li >> 1), pn = (li & 1) * 2 + i, rt = c0 + rtl;
            const int e = (rt >= ts1) + (rt >= ts2) + (rt >= ts3) + (rt >= ts4) + (rt >= ts5) + (rt >= ts6) + (rt >= ts7);
            u.pn = e * ncol + pn; u.on = pn; u.pm = rtl; u.om = rt; return true; }
        long L = (long)i * G + c;
        if (skipn > 0) { const int act = G - skipn; L = (c < skipn) ? 3L * act + (long)i * G + c : ((i < 3) ? (long)i * act + (c - skipn) : 3L * act + (long)(i - 3) * G + c); }
        if (L >= (long)ntc * ncol) return false;
        const int rtl = (int)(L / ncol), pn = (int)(L % ncol), rt = c0 + rtl;
        const int e = (rt >= ts1) + (rt >= ts2) + (rt >= ts3) + (rt >= ts4) + (rt >= ts5) + (rt >= ts6) + (rt >= ts7);
        u.pn = e * ncol + pn; u.on = pn;
        if (up) { u.pm = rt; u.om = rtl; u.ge = e;
            int tse = 0; tse = (e == 1) ? ts1 : tse; tse = (e == 2) ? ts2 : tse; tse = (e == 3) ? ts3 : tse; tse = (e == 4) ? ts4 : tse; tse = (e == 5) ? ts5 : tse; tse = (e == 6) ? ts6 : tse; tse = (e == 7) ? ts7 : tse;
            u.gl = rt - tse; }
        else { u.pm = rtl; u.om = rt; }
        return true;
    }
    __device__ __forceinline__ void a_ready(const Unit&) const {}
    __device__ __forceinline__ void done(const Unit&) const {}
};

__device__ __forceinline__ u32x4 pack8(f32x4 a, f32x4 b) { u32x4 r; r.x = pk2(a.x, a.y); r.y = pk2(a.z, a.w); r.z = pk2(b.x, b.y); r.w = pk2(b.z, b.w); return r; }
struct EpiInProj { bf16* P; static constexpr bool PERM = true;
    __device__ __forceinline__ void emit8(int row, int on, int c, f32x4 lo0, f32x4 lo1, f32x4 hi0, f32x4 hi1) const {
        if (on < 2) { lo0 = gelu4(lo0); lo1 = gelu4(lo1); hi0 = gelu4(hi0); hi1 = gelu4(hi1); } else if (on < 4) { lo0 = lo0 * C2; lo1 = lo1 * C2; hi0 = hi0 * C2; hi1 = hi1 * C2; }
        bf16* rp = P + (size_t)row * PP + on * 256 + c;
        *(u32x4*)rp = pack8(lo0, lo1); *(u32x4*)(rp + 128) = pack8(hi0, hi1);
    }
    __device__ __forceinline__ void emit(int row, int on, int c, f32x4 lo, f32x4 hi) const {
        if (on < 2) { lo = gelu4(lo); hi = gelu4(hi); } else if (on < 4) { lo = lo * C2; hi = hi * C2; }
        bf16* rp = P + (size_t)row * PP + on * 256 + c;
        *(u32x2*)rp = pack4(lo); *(u32x2*)(rp + 128) = pack4(hi);
    } };
struct EpiResid { bf16* xb; static constexpr bool PERM = true;
    __device__ __forceinline__ void emit8(int row, int on, int c, f32x4 lo0, f32x4 lo1, f32x4 hi0, f32x4 hi1) const {
        bf16* rp = xb + (size_t)row * DM + on * 256 + c;
        const u32x4 a = *(const u32x4*)rp, b = *(const u32x4*)(rp + 128);
        const f32x4 a0 = {bflo(a.x), bfhi(a.x), bflo(a.y), bfhi(a.y)}, a1 = {bflo(a.z), bfhi(a.z), bflo(a.w), bfhi(a.w)};
        const f32x4 b0 = {bflo(b.x), bfhi(b.x), bflo(b.y), bfhi(b.y)}, b1 = {bflo(b.z), bfhi(b.z), bflo(b.w), bfhi(b.w)};
        *(u32x4*)rp = pack8(a0 * ALPHA + lo0, a1 * ALPHA + lo1); *(u32x4*)(rp + 128) = pack8(b0 * ALPHA + hi0, b1 * ALPHA + hi1);
    }
    __device__ __forceinline__ void emit(int, int, int, f32x4, f32x4) const {} };
struct EpiSwiglu { bf16* H; int ldh; static constexpr bool PERM = true;
    __device__ __forceinline__ void emit8(int row, int on, int c, f32x4 lo0, f32x4 lo1, f32x4 hi0, f32x4 hi1) const {
        f32x4 v0, v1; v0.x = silu1(lo0.x) * hi0.x; v0.y = silu1(lo0.y) * hi0.y; v0.z = silu1(lo0.z) * hi0.z; v0.w = silu1(lo0.w) * hi0.w;
        v1.x = silu1(lo1.x) * hi1.x; v1.y = silu1(lo1.y) * hi1.y; v1.z = silu1(lo1.z) * hi1.z; v1.w = silu1(lo1.w) * hi1.w;
        const int col = on * 128 + c;
        *(u32x4*)(H + (size_t)(row >> 1) * (2 * ldh) + (col >> 5) * 64 + (row & 1) * 32 + (col & 31)) = pack8(v0, v1);
    }
    __device__ __forceinline__ void emit(int, int, int, f32x4, f32x4) const {} };
constexpr float F8_SC_Y = 16.0f, F8_SC_H = 16.0f, F8_SC_W = 64.0f;
constexpr int F8_E8_Y = 0x7a7a7a7a, F8_E8_H = 0x7a7a7a7a, F8_E8_W = 0x7a7a7a7a;
__device__ __forceinline__ float f8clamp(float v) { return __builtin_amdgcn_fmed3f(v, -448.0f, 448.0f); }
__device__ __forceinline__ unsigned pk4f8(float a, float b, float c, float d) { int p = 0; p = __builtin_amdgcn_cvt_pk_fp8_f32(f8clamp(a), f8clamp(b), p, false); p = __builtin_amdgcn_cvt_pk_fp8_f32(f8clamp(c), f8clamp(d), p, true); return (unsigned)p; }
struct EpiSwiglu8 { unsigned char* H; int ldh; static constexpr bool PERM = true;
    __device__ __forceinline__ void emit8(int row, int on, int c, f32x4 lo0, f32x4 lo1, f32x4 hi0, f32x4 hi1) const {
        f32x4 v0, v1; v0.x = silu1(lo0.x) * hi0.x; v0.y = silu1(lo0.y) * hi0.y; v0.z = silu1(lo0.z) * hi0.z; v0.w = silu1(lo0.w) * hi0.w;
        v1.x = silu1(lo1.x) * hi1.x; v1.y = silu1(lo1.y) * hi1.y; v1.z = silu1(lo1.z) * hi1.z; v1.w = silu1(lo1.w) * hi1.w;
        v0 = v0 * F8_SC_H; v1 = v1 * F8_SC_H;
        *(u32x2*)(H + (size_t)row * ldh + on * 128 + c) = (u32x2){pk4f8(v0.x, v0.y, v0.z, v0.w), pk4f8(v1.x, v1.y, v1.z, v1.w)};
    }
    __device__ __forceinline__ void emit(int, int, int, f32x4, f32x4) const {} };
struct EpiPlain { bf16* O; int ldo; static constexpr bool PERM = true;
    __device__ __forceinline__ void emit8(int row, int on, int c, f32x4 lo0, f32x4 lo1, f32x4 hi0, f32x4 hi1) const {
        bf16* rp = O + (size_t)row * ldo + on * 256 + c;
        *(u32x4*)rp = pack8(lo0, lo1); *(u32x4*)(rp + 128) = pack8(hi0, hi1);
    }
    __device__ __forceinline__ void emit(int row, int on, int c, f32x4 lo, f32x4 hi) const {
        bf16* rp = O + (size_t)row * ldo + on * 256 + c;
        *(u32x2*)rp = pack4(lo); *(u32x2*)(rp + 128) = pack4(hi);
    } };

template <class Epi, class Sched>
__device__ __forceinline__ void ngemm_phase(LAS unsigned char* lds, const Gemm g, const Sched& S, const Epi& E) {
    const int tid = opaque_tid(), ty = tid >> 5, tx = tid & 31;
    LAS float* As = (LAS float*)lds;
    LAS float* Bs = As + 16 * 132;
    Unit u;
    for (int it = 0; S.next(it, u); ++it) {
        for (int half = 0; half < 2; ++half) {
            float acc[8][8];
#pragma unroll
            for (int i = 0; i < 8; ++i)
#pragma unroll
                for (int j = 0; j < 8; ++j) acc[i][j] = 0.f;
            const bf16* Ap = g.A + (size_t)(u.pm * 256 + half * 128 + (tid >> 2)) * g.lda + (tid & 3) * 4;
            const bf16* Bp = g.Bt + (size_t)(u.pn * 256 + (tid >> 1)) * g.K + (tid & 1) * 8;
            for (int k0 = 0; k0 < g.K; k0 += 16) {
                const u32x2 av = *(const u32x2*)(Ap + k0);
                const u32x4 bv = *(const u32x4*)(Bp + k0);
                __syncthreads();
                { LAS float* a = As + ((tid & 3) * 4) * 132 + (tid >> 2);
                  a[0] = bflo(av.x); a[132] = bfhi(av.x); a[264] = bflo(av.y); a[396] = bfhi(av.y);
                  LAS float* b = Bs + ((tid & 1) * 8) * 260 + (tid >> 1);
                  b[0] = bflo(bv.x); b[260] = bfhi(bv.x); b[520] = bflo(bv.y); b[780] = bfhi(bv.y);
                  b[1040] = bflo(bv.z); b[1300] = bfhi(bv.z); b[1560] = bflo(bv.w); b[1820] = bfhi(bv.w); }
                __syncthreads();
#pragma unroll 2
                for (int kk = 0; kk < 16; ++kk) {
                    const f32x4 a0 = *(const LAS f32x4*)(As + kk * 132 + ty * 8), a1 = *(const LAS f32x4*)(As + kk * 132 + ty * 8 + 4);
                    const f32x4 b0 = *(const LAS f32x4*)(Bs + kk * 260 + tx * 4), b1 = *(const LAS f32x4*)(Bs + kk * 260 + 128 + tx * 4);
                    const float a[8] = {a0.x, a0.y, a0.z, a0.w, a1.x, a1.y, a1.z, a1.w};
                    const float b[8] = {b0.x, b0.y, b0.z, b0.w, b1.x, b1.y, b1.z, b1.w};
#pragma unroll
                    for (int i = 0; i < 8; ++i)
#pragma unroll
                        for (int j = 0; j < 8; ++j) acc[i][j] += a[i] * b[j];
                }
            }
#pragma unroll
            for (int i = 0; i < 8; ++i) {
                const f32x4 lo = {acc[i][0], acc[i][1], acc[i][2], acc[i][3]}, hi = {acc[i][4], acc[i][5], acc[i][6], acc[i][7]};
                E.emit(u.om * 256 + half * 128 + ty * 8 + i, u.on, tx * 4, lo, hi);
            }
        }
    }
    __syncthreads();
}


namespace pg8 {
__device__ __forceinline__ void glds_so(unsigned long long sbase, unsigned voff, unsigned lds_dst) { unsigned keep;
    asm volatile("s_mov_b32 %0, m0\n\ts_mov_b32 m0, %3\n\ts_nop 0\n\tglobal_load_lds_dwordx4 %1, %2\n\ts_mov_b32 m0, %0" : "=&s"(keep) : "v"(voff), "s"(sbase), "s"(lds_dst) : "memory"); }
typedef short bf16x8 __attribute__((ext_vector_type(8)));
typedef int i32x4_t __attribute__((ext_vector_type(4)));
typedef int i32x8_t __attribute__((ext_vector_type(8)));
typedef short s16x16_t __attribute__((ext_vector_type(16)));
constexpr int BM = 256, BK = 64, HALF = 128, HTB = HALF * BK * 2, STAGE_BYTES = 8 * HTB;
__device__ __forceinline__ int lds_byte(int r, int c) { const int st = (r >> 4) * 2 + (c >> 5), rr = r & 15, cc = c & 31, ob = rr * 64 + cc * 2; return st * 1024 + (ob ^ (((ob >> 9) & 1) << 5)); }
__device__ __forceinline__ int perm32(int rho) { const int n = rho >> 4, i = rho & 15; return 8 * (i >> 2) + 4 * n + (i & 3); }
__device__ __forceinline__ void stage_rc(int b, int& R, int& C) { const int st = b / 1024, sb = b % 1024, swz = sb ^ (((sb >> 9) & 1) << 5); R = (st >> 1) * 16 + swz / 64; C = (st & 1) * 32 + (swz % 64) / 2; }
template <class Epi, class Sched, bool GATHER = false, bool PAIRA = false, bool F8 = false>
__device__ __forceinline__ void gemm_phase(LAS unsigned char* lds, const Gemm g, const Sched& S, const Epi& E) {
    const int tid = opaque_tid(), wid = __builtin_amdgcn_readfirstlane(tid >> 6), lane = tid & 63, wr = wid >> 2, wc = wid & 3, fr = lane & 15, fq = lane >> 4;
    const int K = g.K, nt = F8 ? K / 128 : K / BK, lda = g.lda; const int sc2 = g.sa;
    unsigned voffA[2], voffB[2];
#pragma unroll
    for (int i = 0; i < 2; ++i) { int R, C; stage_rc(tid * 16 + i * 8192, R, C); const int Rb = Epi::PERM ? ((R & ~31) + perm32(R & 31)) : R;
        voffA[i] = F8 ? (unsigned)(R * lda + 2 * C) : PAIRA ? (unsigned)((R >> 1) * (2 * lda) + (C >> 5) * 64 + (R & 1) * 32 + (C & 31)) * 2u : (unsigned)(R * lda + C) * 2u; voffB[i] = F8 ? (unsigned)(Rb * K + 2 * C) : (unsigned)(Rb * K + C) * 2u; }
    const size_t kstep = (size_t)(BK * 2), kstepA = PAIRA ? 2 * kstep : kstep;
    const size_t hstepA = (size_t)HALF * lda * (F8 ? 1 : 2), hstepB = (size_t)HALF * K * (F8 ? 1 : 2);
    const size_t tstepA = 2 * hstepA, tstepB = 2 * hstepB;
    const unsigned ldsw = (unsigned)wid * 1024u;
    const unsigned ldsb = (unsigned)__builtin_amdgcn_readfirstlane((int)((unsigned)(uintptr_t)lds + ldsw));
    const int loff = F8 ? lds_byte(fr, fq * 16) : lds_byte(fr, fq * 8); const int aoff = wr * 8192 + loff, boff = wc * 4096 + loff;
#define PG8_SA(b, h) (((b) * 2 + (h)) * HTB)
#define PG8_SB(b, h) ((4 + (b) * 2 + (h)) * HTB)
#define PG8_STAGE(bufoff, gbase, voff) do { \
        if constexpr (F8) { const unsigned long long b_ = (unsigned long long)(gbase); \
            const unsigned long long sb_ = ((unsigned long long)(unsigned)__builtin_amdgcn_readfirstlane((int)(b_ >> 32)) << 32) | (unsigned)__builtin_amdgcn_readfirstlane((int)b_); \
            const bool isB_ = ((const void*)(voff) == (const void*)voffB), isA_ = ((const void*)(voff) == (const void*)voffA);     \
            if (isB_ || isA_) { const unsigned long long d_ = 64ull * (unsigned)(isB_ ? K : lda);     \
                glds_so(sb_, (voff)[0], ldsb + (unsigned)(bufoff)); glds_so(sb_ + d_, (voff)[0], ldsb + (unsigned)((bufoff) + 8192)); } \
            else { _Pragma("unroll") for (int _i = 0; _i < 2; ++_i) glds_so(sb_, (voff)[_i], ldsb + (unsigned)((bufoff) + _i * 8192)); } }     \
        else { _Pragma("unroll") for (int _i = 0; _i < 2; ++_i) __builtin_amdgcn_global_load_lds((const unsigned*)((const char*)(gbase) + (voff)[_i]), (LAS unsigned*)(lds + (bufoff) + ldsw + _i * 8192), 16, 0, 0); } } while (0)
#define PG8_LDA(dst, b, h) do { if constexpr (F8) { _Pragma("unroll") for (int m = 0; m < 4; ++m) dst##8[m] = __builtin_bit_cast(i32x8_t, *(const LAS s16x16_t*)(lds + PG8_SA(b, h) + aoff + m * 2048)); } \
        else { _Pragma("unroll") for (int m = 0; m < 4; ++m) _Pragma("unroll") for (int k = 0; k < 2; ++k) dst[m][k] = *(const LAS bf16x8*)(lds + PG8_SA(b, h) + aoff + m * 2048 + k * 1024); } } while (0)
#define PG8_LDB(dst, b, h) do { if constexpr (F8) { _Pragma("unroll") for (int n = 0; n < 2; ++n) dst##8[n] = __builtin_bit_cast(i32x8_t, *(const LAS s16x16_t*)(lds + PG8_SB(b, h) + boff + n * 2048)); } \
        else { _Pragma("unroll") for (int n = 0; n < 2; ++n) _Pragma("unroll") for (int k = 0; k < 2; ++k) dst[n][k] = *(const LAS bf16x8*)(lds + PG8_SB(b, h) + boff + n * 2048 + k * 1024); } } while (0)
#define PG8_CAT(a_, b_) __builtin_shufflevector(__builtin_bit_cast(i32x4_t, a_), __builtin_bit_cast(i32x4_t, b_), 0, 1, 2, 3, 4, 5, 6, 7)
#define PG8_MMA(ai, bj, At, Bt) do { __builtin_amdgcn_s_setprio(1); \
        if constexpr (F8) { _Pragma("unroll") for (int m = 0; m < 4; ++m) _Pragma("unroll") for (int n = 0; n < 2; ++n) \
            acc[ai][bj][m][n] = __builtin_amdgcn_mfma_scale_f32_16x16x128_f8f6f4(Bt##8[n], At##8[m], acc[ai][bj][m][n], 0, 0, 0, sc2, 0, sc2); } \
        else { _Pragma("unroll") for (int m = 0; m < 4; ++m) _Pragma("unroll") for (int n = 0; n < 2; ++n) _Pragma("unroll") for (int k = 0; k < 2; ++k) \
            acc[ai][bj][m][n] = __builtin_amdgcn_mfma_f32_16x16x32_bf16(Bt[n][k], At[m][k], acc[ai][bj][m][n], 0, 0, 0); } \
        __builtin_amdgcn_s_setprio(0); } while (0)
#define PG8_WAIT_V(n) asm volatile("s_waitcnt vmcnt(" #n ")" ::: "memory")
#define PG8_WAIT_L(n) asm volatile("s_waitcnt lgkmcnt(" #n ")" ::: "memory")
#define PG8_BAR __builtin_amdgcn_s_barrier()
#define PG8_SCHED __builtin_amdgcn_sched_barrier(0)
    Unit cur, nxt; int ui = 0;
    if (!S.next(0, cur)) return;
    unsigned gA0[2] = {0u, 0u}, gA1[2] = {0u, 0u};
    const char* gbaseA = (const char*)g.A;
#define PG8_GLOAD(u, r) do { _Pragma("unroll") for (int i_ = 0; i_ < 2; ++i_) { int R_, C_; stage_rc(tid * 16 + i_ * 8192, R_, C_); const int* tp_ = S.rowtok + ((u).ge * 32768 + (u).gl * 256 + R_); r[2 * i_] = tp_[0]; r[2 * i_ + 1] = tp_[128]; } } while (0)
#define PG8_GOFF(r, o0, o1) do { _Pragma("unroll") for (int i_ = 0; i_ < 2; ++i_) { int R_, C_; stage_rc(tid * 16 + i_ * 8192, R_, C_); o0[i_] = F8 ? (unsigned)(r[2 * i_] * lda + 2 * C_) : (unsigned)(r[2 * i_] * lda + C_) * 2u; o1[i_] = F8 ? (unsigned)(r[2 * i_ + 1] * lda + 2 * C_) : (unsigned)(r[2 * i_ + 1] * lda + C_) * 2u; } } while (0)
#define PG8_STAGE_A(bufoff, ptr, kofs, offs) do { if constexpr (GATHER) PG8_STAGE(bufoff, gbaseA + (kofs), offs); else PG8_STAGE(bufoff, ptr, voffA); } while (0)
    int raw[4] = {0, 0, 0, 0};
    if constexpr (GATHER) { PG8_GLOAD(cur, raw); PG8_GOFF(raw, gA0, gA1); }
    f32x4 acc[2][2][4][2];
#pragma unroll
    for (int a = 0; a < 2; ++a)
#pragma unroll
        for (int b = 0; b < 2; ++b)
#pragma unroll
            for (int m = 0; m < 4; ++m)
#pragma unroll
                for (int n = 0; n < 2; ++n) acc[a][b][m][n] = (f32x4){0.f, 0.f, 0.f, 0.f};
    bf16x8 At[4][2], B0[2][2], B1[2][2]; i32x8_t At8[4], B08[2], B18[2];
#define PG8_SPTR(p_) (F8 ? (const char*)(((unsigned long long)(unsigned)__builtin_amdgcn_readfirstlane((int)((unsigned long long)(p_) >> 32)) << 32) | (unsigned)__builtin_amdgcn_readfirstlane((int)(unsigned long long)(p_))) : (const char*)(p_))
    const char* cA = PG8_SPTR((const char*)g.A + (size_t)cur.pm * tstepA); const char* cB = PG8_SPTR((const char*)g.Bt + (size_t)cur.pn * tstepB);
    S.a_ready(cur);
    PG8_STAGE(PG8_SB(0, 0), cB, voffB); PG8_STAGE(PG8_SB(0, 1), cB + hstepB, voffB); PG8_STAGE_A(PG8_SA(0, 0), cA, 0, gA0); PG8_STAGE_A(PG8_SA(0, 1), cA + hstepA, 0, gA1);
    if (wr == 1) PG8_BAR;
    PG8_WAIT_V(2); PG8_BAR;
    PG8_STAGE(PG8_SB(1, 0), cB + kstep, voffB); PG8_STAGE_A(PG8_SA(1, 0), cA + kstepA, kstep, gA0); PG8_STAGE(PG8_SB(1, 1), cB + hstepB + kstep, voffB);
    PG8_WAIT_V(6); PG8_BAR;
    for (;;) {
        const bool has_next = S.next(ui + 1, nxt);
        const char* nA = PG8_SPTR(has_next ? (const char*)g.A + (size_t)nxt.pm * tstepA : cA); const char* nB = PG8_SPTR(has_next ? (const char*)g.Bt + (size_t)nxt.pn * tstepB : cB);
        const bool gsw = GATHER && has_next && (nxt.ge != cur.ge || nxt.gl != cur.gl);
#pragma unroll 1
        for (int t = 0; t < nt; t += 2) {
            const bool last = (t == nt - 2);
            const size_t k1 = (size_t)(t + 1) * kstep, k2 = last ? (size_t)0 : (size_t)(t + 2) * kstep, k3 = k2 + kstep;
            const char* a1 = cA + (size_t)(t + 1) * kstepA;
            const char* a2 = last ? nA : cA + (size_t)(t + 2) * kstepA; const char* b2 = last ? nB : cB + (size_t)(t + 2) * kstep;
            const char* a3 = a2 + kstepA; const char* b3 = b2 + kstep;
            if (last && has_next) S.a_ready(nxt);
            PG8_LDB(B0, 0, 0); PG8_LDB(B1, 0, 1); PG8_SCHED; PG8_LDA(At, 0, 0); PG8_STAGE_A(PG8_SA(1, 1), a1 + hstepA, k1, gA1);
            if constexpr (GATHER) { if (last && gsw) { PG8_GLOAD(nxt, raw); PG8_GOFF(raw, gA0, gA1); } }
            PG8_WAIT_V(8); PG8_WAIT_L(0); PG8_BAR; PG8_MMA(0, 0, At, B0); PG8_MMA(0, 1, At, B1); PG8_BAR; PG8_SCHED;
            PG8_LDA(At, 0, 1); PG8_STAGE(PG8_SB(0, 0), b2, voffB); PG8_STAGE(PG8_SB(0, 1), b2 + hstepB, voffB); PG8_STAGE_A(PG8_SA(0, 0), a2, k2, gA0);
            PG8_WAIT_V(8); PG8_WAIT_L(0); PG8_BAR; PG8_MMA(1, 0, At, B0); PG8_MMA(1, 1, At, B1); PG8_BAR; PG8_SCHED;
            PG8_LDB(B0, 1, 0); PG8_LDB(B1, 1, 1); PG8_SCHED; PG8_LDA(At, 1, 0); PG8_STAGE_A(PG8_SA(0, 1), a2 + hstepA, k2, gA1);
            PG8_WAIT_V(8); PG8_WAIT_L(0); PG8_BAR; PG8_MMA(0, 0, At, B0); PG8_MMA(0, 1, At, B1); PG8_BAR; PG8_SCHED;
            PG8_LDA(At, 1, 1); PG8_STAGE(PG8_SB(1, 0), b3, voffB); PG8_STAGE(PG8_SB(1, 1), b3 + hstepB, voffB); PG8_STAGE_A(PG8_SA(1, 0), a3, k3, gA0);
            PG8_WAIT_V(8); PG8_WAIT_L(0); PG8_BAR; PG8_MMA(1, 0, At, B0); PG8_MMA(1, 1, At, B1); PG8_BAR; PG8_SCHED;
        }
        if (wr == 0) PG8_BAR;
        {
            int fr_e = fr, fq_e = fq;
            if constexpr (F8) { const int l2_ = opaque_tid() & 63; fr_e = l2_ & 15; fq_e = l2_ >> 4; }
#pragma unroll
            for (int ai = 0; ai < 2; ++ai)
#pragma unroll
                for (int m = 0; m < 4; ++m) { const int row = cur.om * BM + ai * HALF + wr * 64 + m * 16 + fr_e;
                    if constexpr (Epi::PERM) E.emit8(row, cur.on, wc * 32 + 8 * fq_e, acc[ai][0][m][0], acc[ai][0][m][1], acc[ai][1][m][0], acc[ai][1][m][1]);
                    else {
#pragma unroll
                    for (int n = 0; n < 2; ++n) E.emit(row, cur.on, wc * 32 + n * 16 + fq * 4, acc[ai][0][m][n], acc[ai][1][m][n]); } }
            S.done(cur);
        }
        if (!has_next) break;
#pragma unroll
        for (int a = 0; a < 2; ++a)
#pragma unroll
            for (int b = 0; b < 2; ++b)
#pragma unroll
                for (int m = 0; m < 4; ++m)
#pragma unroll
                    for (int n = 0; n < 2; ++n) acc[a][b][m][n] = (f32x4){0.f, 0.f, 0.f, 0.f};
        cur = nxt; cA = nA; cB = nB; ++ui;
        if (wr == 1) PG8_BAR;
    }
    PG8_WAIT_V(0);
    PG8_BAR;
#undef PG8_SA
#undef PG8_SB
#undef PG8_STAGE
#undef PG8_STAGE_A
#undef PG8_SPTR
#undef PG8_GLOAD
#undef PG8_GOFF
#undef PG8_LDA
#undef PG8_LDB
#undef PG8_MMA
#undef PG8_CAT
#undef PG8_WAIT_V
#undef PG8_WAIT_L
#undef PG8_BAR
#undef PG8_SCHED
}
}
#ifndef USE_NAIVE_GEMM
#define GEMM_PHASE pg8::gemm_phase
#else
#define GEMM_PHASE ngemm_phase
#endif

struct Args { const float* in[24]; float* out; unsigned char* ws; };
enum { I_X = 0, I_WIN, I_WOUT, I_GWS, I_GBS, I_LQ1, I_LK1, I_LQ2, I_LK2, I_SUBG, I_RELB, I_POOLW, I_POOLS, I_LN1G, I_LN1B, I_LN2G, I_LN2B,
       I_FW1, I_FW3, I_FW2, I_RW, I_MW1, I_MW3, I_MW2 };

__device__ __forceinline__ void tr_item8(const float* src, int ld, int k0s, int n0s, unsigned char* dst, int ldd, int n0d, int k0d, LAS float* scr, int lane) {
#pragma unroll 8
    for (int i = 0; i < 32; ++i) { const int kk = 2 * i + (lane >> 5); scr[kk * 33 + (lane & 31)] = __builtin_nontemporal_load(src + (size_t)(k0s + kk) * ld + n0s + (lane & 31)) * F8_SC_W; }
    asm volatile("s_waitcnt lgkmcnt(0)" ::: "memory");
    const int c = lane & 3;
#pragma unroll
    for (int j = 0; j < 2; ++j) { const int n = (lane >> 2) + 16 * j; const LAS float* q = scr + (16 * c) * 33 + n;
        u32x4 o; o.x = pk4f8(q[0 * 33], q[1 * 33], q[2 * 33], q[3 * 33]); o.y = pk4f8(q[4 * 33], q[5 * 33], q[6 * 33], q[7 * 33]);
        o.z = pk4f8(q[8 * 33], q[9 * 33], q[10 * 33], q[11 * 33]); o.w = pk4f8(q[12 * 33], q[13 * 33], q[14 * 33], q[15 * 33]);
        *(u32x4*)(dst + (size_t)(n0d + n) * ldd + k0d + 16 * c) = o; }
    asm volatile("s_waitcnt lgkmcnt(0)" ::: "memory");
}
__device__ __forceinline__ void tr_item(const float* src, int ld, int k0s, int n0s, bf16* dst, int ldd, int n0d, int k0d, LAS float* scr, int lane) {
#pragma unroll 8
    for (int i = 0; i < 32; ++i) { const int kk = 2 * i + (lane >> 5); scr[kk * 33 + (lane & 31)] = __builtin_nontemporal_load(src + (size_t)(k0s + kk) * ld + n0s + (lane & 31)); }
    asm volatile("s_waitcnt lgkmcnt(0)" ::: "memory");
    const int c = lane & 7;
#pragma unroll
    for (int j = 0; j < 4; ++j) { const int n = (lane >> 3) + 8 * j; const LAS float* s = scr + (8 * c) * 33 + n;
        u32x4 o; o.x = pk2(s[0 * 33], s[1 * 33]); o.y = pk2(s[2 * 33], s[3 * 33]); o.z = pk2(s[4 * 33], s[5 * 33]); o.w = pk2(s[6 * 33], s[7 * 33]);
        *(u32x4*)(dst + (size_t)(n0d + n) * ldd + k0d + 8 * c) = o; }
    asm volatile("s_waitcnt lgkmcnt(0)" ::: "memory");
}

__device__ __forceinline__ void prologue(const Args& a, LAS unsigned char* lds, int gw, int NGW, int wave, int lane_) {
    int lane = lane_; asm volatile("" : "+v"(lane));
    unsigned char* ws = a.ws;
    LAS float* scr = (LAS float*)(lds + wave * 16384);
    for (int i = gw * 64 + lane; i < 2 * 4 * 128 * 128; i += NGW * 64) { const int s_ = i & 127, t_ = (i >> 7) & 127; ((bf16*)(ws + WS_WB))[i] = (s_ <= t_) ? (bf16)f2bf(a.in[I_GWS][i]) : (bf16)0; }
    for (int i = gw * 64 + lane; i < 2 * 4 * 64 * 64; i += NGW * 64) { const int c_ = i & 63, d_ = (i >> 6) & 63, lg = i >> 12; ((bf16*)(ws + WS_PWT))[i] = (bf16)f2bf(a.in[I_POOLW][lg * 4096 + c_ * 64 + d_]); }
    for (int i = gw * 64 + lane; i < 8 * 32768; i += NGW * 64) ((int*)(ws + WS_ROWTOK))[i] = 0;
    constexpr int N_WIN = 16 * 72, N_WOUT = 16 * 32, N_W13 = 176 * 16, N_W2 = 44 * 32, N_MW13 = 224 * 16, N_MW2 = 56 * 32;
    constexpr int TOT = 2 * N_WIN + 2 * N_WOUT + N_W13 + N_W2 + 8 * N_MW13 + 8 * N_MW2;
    for (int it = gw; it < TOT; it += NGW) {
        int r = it;
        if (r < 2 * N_WIN) { const int l = r / N_WIN; r %= N_WIN; const int kb = r / 72, nb = r % 72;
            tr_item(a.in[I_WIN] + (size_t)l * DM * DIN, DIN, 64 * kb, 32 * nb, (bf16*)(ws + WS_WIN) + (size_t)l * DIN * DM, DM, 32 * nb, 64 * kb, scr, lane); continue; }
        r -= 2 * N_WIN;
        if (r < 2 * N_WOUT) { const int l = r / N_WOUT; r %= N_WOUT; const int kb = r / 32, nb = r % 32; const int kd = 64 * kb;
            const int ks = kd < 256 ? kd : (kd < 512 ? kd + 512 : kd - 256);
            tr_item(a.in[I_WOUT] + (size_t)l * DM * DM, DM, ks, 32 * nb, (bf16*)(ws + WS_WOUT) + (size_t)l * DM * DM, DM, 32 * nb, kd, scr, lane); continue; }
        r -= 2 * N_WOUT;
        if (r < N_W13) { const int nb = r / 16, kb = r % 16; const int nd = 32 * nb, t = nd >> 8, s = (nd >> 7) & 1, j0 = nd & 127;
            tr_item(a.in[s ? I_FW3 : I_FW1], DFF, 64 * kb, 128 * t + j0, (bf16*)(ws + WS_W13), DM, nd, 64 * kb, scr, lane); continue; }
        r -= N_W13;
        if (r < N_W2) { const int kb = r / 32, nb = r % 32;
            tr_item8(a.in[I_FW2], DM, 64 * kb, 32 * nb, (unsigned char*)(ws + WS_W2), DFF, 32 * nb, 64 * kb, scr, lane); continue; }
        r -= N_W2;
        if (r < 8 * N_MW13) { const int e = r / N_MW13; r %= N_MW13; const int nb = r / 16, kb = r % 16; const int nd = 32 * nb, t = nd >> 8, s = (nd >> 7) & 1, j0 = nd & 127;
            tr_item8(a.in[s ? I_MW3 : I_MW1] + (size_t)e * DM * DFE, DFE, 64 * kb, 128 * t + j0, (unsigned char*)(ws + WS_MW13) + (size_t)e * 2 * DFE * DM, DM, nd, 64 * kb, scr, lane); continue; }
        r -= 8 * N_MW13;
        { const int e = r / N_MW2; r %= N_MW2; const int kb = r / 32, nb = r % 32;
            tr_item8(a.in[I_MW2] + (size_t)e * DFE * DM, DM, 64 * kb, 32 * nb, (unsigned char*)(ws + WS_MW2) + (size_t)e * DM * DFE, DFE, 32 * nb, 64 * kb, scr, lane); }
    }
    bf16* xb = (bf16*)(ws + WS_XB);
    for (int m0 = gw; m0 < M; m0 += 4 * NGW) {
        f32x4 xv[4][4];
#pragma unroll
        for (int k = 0; k < 4; ++k) { const f32x4* xr = (const f32x4*)(a.in[I_X] + (size_t)(m0 + k * NGW) * DM) + lane;
#pragma unroll
            for (int j = 0; j < 4; ++j) xv[k][j] = __builtin_nontemporal_load(xr + 64 * j); }
#pragma unroll
        for (int k = 0; k < 4; ++k) { u32x2* o = (u32x2*)(xb + (size_t)(m0 + k * NGW) * DM) + lane;
#pragma unroll
            for (int j = 0; j < 4; ++j) o[64 * j] = pack4(xv[k][j]); }
    }
}

__device__ __forceinline__ void chunk_unit(LAS unsigned char* lds, bf16* P, int chunk, const bf16* Wb, const float* gbs, const bf16* PwT, const float* psc) {
    typedef pg8::bf16x8 bf16x8;
    const int tid = opaque_tid(), lane = tid & 63, wv = __builtin_amdgcn_readfirstlane(tid >> 6), fr = lane & 15, fq = lane >> 4;
    const size_t r0 = (size_t)chunk * 128;
    const int tpos0 = (chunk % (SEQ / 128)) * 128;
    const int trow = 16 * wv + fr;
    {
        LAS bf16* VnT = (LAS bf16*)lds;
        const int nks = (wv >> 1) + 1;
        for (int h = 0; h < 4; ++h) {
            __syncthreads();
            {   const int sI = tid >> 2, qd = (tid & 3) * 16;
                const bf16* vp = P + (r0 + sI) * PP + PC_V + h * 64 + qd;
                const u32x4 w0 = __builtin_nontemporal_load((const u32x4*)vp), w1 = __builtin_nontemporal_load((const u32x4*)(vp + 8));
                float v[16] = {bflo(w0.x), bfhi(w0.x), bflo(w0.y), bfhi(w0.y), bflo(w0.z), bfhi(w0.z), bflo(w0.w), bfhi(w0.w),
                               bflo(w1.x), bfhi(w1.x), bflo(w1.y), bfhi(w1.y), bflo(w1.z), bfhi(w1.z), bflo(w1.w), bfhi(w1.w)};
                float sum = 0.f;
#pragma unroll
                for (int i = 0; i < 16; ++i) sum += v[i];
                sum += shx(sum, lane, 1); sum += shx(sum, lane, 2);
                const float mu = sum * (1.f / 64.f); float sq = 0.f;
#pragma unroll
                for (int i = 0; i < 16; ++i) { v[i] -= mu; sq += v[i] * v[i]; }
                sq += shx(sq, lane, 1); sq += shx(sq, lane, 2);
                const float rstd = 1.0f / sqrtf(sq * (1.f / 64.f) + LN_EPS);
#pragma unroll
                for (int i = 0; i < 16; ++i) VnT[(qd + i) * 136 + sI] = (bf16)f2bf(v[i] * rstd);
            }
            bf16x8 af[4];
#pragma unroll
            for (int ks = 0; ks < 4; ++ks) af[ks] = (ks < nks) ? *(const bf16x8*)(Wb + ((size_t)(h * 128 + trow) * 128 + 32 * ks + 8 * fq)) : (bf16x8){0, 0, 0, 0, 0, 0, 0, 0};
            __syncthreads();
            f32x4 acc[4];
#pragma unroll
            for (int j = 0; j < 4; ++j) acc[j] = (f32x4){0.f, 0.f, 0.f, 0.f};
#pragma unroll
            for (int ks = 0; ks < 4; ++ks) if (ks < nks) {
#pragma unroll
                for (int j = 0; j < 4; ++j) { const bf16x8 bfr = *(const LAS bf16x8*)(VnT + (16 * j + fr) * 136 + 32 * ks + 8 * fq);
                    acc[j] = __builtin_amdgcn_mfma_f32_16x16x32_bf16(bfr, af[ks], acc[j], 0, 0, 0); } }
            const float bias = gbs[h * 128 + trow];
#pragma unroll
            for (int j = 0; j < 4; ++j) { bf16* up = P + (r0 + trow) * PP + PC_U + h * 64 + 16 * j + 4 * fq; const u32x2 uw = *(const u32x2*)up;
                f32x4 o; o.x = bflo(uw.x) * (acc[j].x + bias); o.y = bfhi(uw.x) * (acc[j].y + bias); o.z = bflo(uw.y) * (acc[j].z + bias); o.w = bfhi(uw.y) * (acc[j].w + bias);
                *(u32x2*)up = pack4(o); }
        }
    }
    {
        LAS float* Cs = (LAS float*)lds;
        LAS bf16* Yb = (LAS bf16*)(lds + 40960);
        for (int g = 0; g < 4; ++g) {
            __syncthreads();
            for (int idx = tid; idx < 143 * 8; idx += NTHR) { const int rr = idx >> 3, c8 = (idx & 7) * 8, trel = rr - 15;
                f32x4 a = {0.f, 0.f, 0.f, 0.f}, b = {0.f, 0.f, 0.f, 0.f};
                if (tpos0 + trel >= 0) { const u32x4 w = __builtin_nontemporal_load((const u32x4*)(P + (size_t)((long)r0 + trel) * PP + PC_C + g * 64 + c8));
                    a = (f32x4){bflo(w.x), bfhi(w.x), bflo(w.y), bfhi(w.y)}; b = (f32x4){bflo(w.z), bfhi(w.z), bflo(w.w), bfhi(w.w)}; }
                *(LAS f32x4*)(Cs + rr * 64 + c8) = a; *(LAS f32x4*)(Cs + rr * 64 + c8 + 4) = b; }
            bf16x8 bfr[4][2];
#pragma unroll
            for (int j = 0; j < 4; ++j)
#pragma unroll
                for (int ks = 0; ks < 2; ++ks) bfr[j][ks] = *(const bf16x8*)(PwT + ((size_t)(g * 64 + 16 * j + fr) * 64 + 32 * ks + 8 * fq));
            __syncthreads();
            {   const int t = tid >> 2, cq = (tid & 3) * 16, win = 2 << g; const int tp = tpos0 + t; const int cnt = (tp + 1) < win ? (tp + 1) : win;
                const float rc = 1.0f / (float)cnt;
#pragma unroll
                for (int i = 0; i < 4; ++i) { f32x4 sm = {0.f, 0.f, 0.f, 0.f};
                    for (int j = 0; j < cnt; ++j) sm += *(const LAS f32x4*)(Cs + (t + 15 - j) * 64 + cq + 4 * i);
                    const f32x4 self = *(const LAS f32x4*)(Cs + (t + 15) * 64 + cq + 4 * i);
                    *(LAS u32x2*)(Yb + t * 72 + cq + 4 * i) = pack4(sm * rc - self); }
            }
            __syncthreads();
            f32x4 acc[4];
#pragma unroll
            for (int j = 0; j < 4; ++j) acc[j] = (f32x4){0.f, 0.f, 0.f, 0.f};
#pragma unroll
            for (int ks = 0; ks < 2; ++ks) { const bf16x8 af = *(const LAS bf16x8*)(Yb + trow * 72 + 32 * ks + 8 * fq);
#pragma unroll
                for (int j = 0; j < 4; ++j) acc[j] = __builtin_amdgcn_mfma_f32_16x16x32_bf16(bfr[j][ks], af, acc[j], 0, 0, 0); }
#pragma unroll
            for (int j = 0; j < 4; ++j) { const int d = 16 * j + 4 * fq; const f32x4 sc = *(const f32x4*)(psc + g * 64 + d);
                *(u32x2*)(P + (r0 + trow) * PP + PC_V + g * 64 + d) = pack4(acc[j] * sc); }
        }
    }
    __syncthreads();
}

__device__ __forceinline__ int t5_bucket(int n) {
    if (n < 16) return n;
    int v = 16 + (int)(logf((float)n * (1.0f / 16.0f)) * (16.0f / 2.0794415416798357f));
    return v < 31 ? v : 31;
}
__device__ __forceinline__ void nattn_unit(LAS unsigned char* lds, bf16* P, int b, int h, int qt, const LAS float* btab, float lam, const float* subg, float omli) {
    const int tid = opaque_tid(), row = tid >> 3, m = (tid >> 2) & 1, dq = tid & 3;
    LAS float* Ks = (LAS float*)lds;
    LAS float* Vs = Ks + 64 * 128;
    const size_t rowq = (size_t)b * SEQ + qt * 64 + row;
    float q[16];
    {   const bf16* qp = P + rowq * PP + PC_Q + h * 128 + m * 64 + dq * 16;
#pragma unroll
        for (int i = 0; i < 2; ++i) { const u32x4 v = *(const u32x4*)(qp + 8 * i);
            q[8 * i] = bflo(v.x); q[8 * i + 1] = bfhi(v.x); q[8 * i + 2] = bflo(v.y); q[8 * i + 3] = bfhi(v.y); q[8 * i + 4] = bflo(v.z); q[8 * i + 5] = bfhi(v.z); q[8 * i + 6] = bflo(v.w); q[8 * i + 7] = bfhi(v.w); } }
    float o[32];
#pragma unroll
    for (int d = 0; d < 32; ++d) o[d] = 0.f;
    float mr = -INFINITY, l = 0.f;
    const int qpos = qt * 64 + row;
    for (int kt = 0; kt <= qt; ++kt) {
        __syncthreads();
        {   const int key = tid >> 3, c16 = (tid & 7) * 16;
            const bf16* kp = P + ((size_t)b * SEQ + kt * 64 + key) * PP + PC_K + h * 128 + c16;
            const u32x4 k0 = *(const u32x4*)kp, k1 = *(const u32x4*)(kp + 8), v0 = *(const u32x4*)(kp + 512), v1 = *(const u32x4*)(kp + 520);
            LAS float* kd = Ks + key * 128 + c16; LAS float* vd = Vs + key * 128 + c16;
            *(LAS f32x4*)(kd) = (f32x4){bflo(k0.x), bfhi(k0.x), bflo(k0.y), bfhi(k0.y)}; *(LAS f32x4*)(kd + 4) = (f32x4){bflo(k0.z), bfhi(k0.z), bflo(k0.w), bfhi(k0.w)};
            *(LAS f32x4*)(kd + 8) = (f32x4){bflo(k1.x), bfhi(k1.x), bflo(k1.y), bfhi(k1.y)}; *(LAS f32x4*)(kd + 12) = (f32x4){bflo(k1.z), bfhi(k1.z), bflo(k1.w), bfhi(k1.w)};
            *(LAS f32x4*)(vd) = (f32x4){bflo(v0.x), bfhi(v0.x), bflo(v0.y), bfhi(v0.y)}; *(LAS f32x4*)(vd + 4) = (f32x4){bflo(v0.z), bfhi(v0.z), bflo(v0.w), bfhi(v0.w)};
            *(LAS f32x4*)(vd + 8) = (f32x4){bflo(v1.x), bfhi(v1.x), bflo(v1.y), bfhi(v1.y)}; *(LAS f32x4*)(vd + 12) = (f32x4){bflo(v1.z), bfhi(v1.z), bflo(v1.w), bfhi(v1.w)};
        }
        __syncthreads();
        const int kbase = kt * 64;
        for (int j0 = 0; j0 < 64; j0 += 4) {
            float s[4];
#pragma unroll
            for (int jj = 0; jj < 4; ++jj) { const LAS float* kr = Ks + (j0 + jj) * 128 + m * 64 + dq * 16; float a = 0.f;
#pragma unroll
                for (int d = 0; d < 16; d += 4) { const f32x4 kv = *(const LAS f32x4*)(kr + d); a += q[d] * kv.x + q[d + 1] * kv.y + q[d + 2] * kv.z + q[d + 3] * kv.w; }
                a += __shfl_xor(a, 1); a += __shfl_xor(a, 2); s[jj] = a; }
            float gm = mr;
#pragma unroll
            for (int jj = 0; jj < 4; ++jj) { const int dist = qpos - (kbase + j0 + jj);
                if (dist < 0) s[jj] = -INFINITY; else if (dist < 128) s[jj] += btab[dist];
                gm = fmaxf(gm, s[jj]); }
            const float sc = __builtin_amdgcn_exp2f(mr - gm);
            mr = gm; l *= sc;
#pragma unroll
            for (int d = 0; d < 32; ++d) o[d] *= sc;
#pragma unroll
            for (int jj = 0; jj < 4; ++jj) { const float pj = __builtin_amdgcn_exp2f(s[jj] - gm); l += pj;
                const LAS float* vr = Vs + (j0 + jj) * 128 + dq * 32;
#pragma unroll
                for (int d = 0; d < 32; d += 4) { const f32x4 vv = *(const LAS f32x4*)(vr + d); o[d] += pj * vv.x; o[d + 1] += pj * vv.y; o[d + 2] += pj * vv.z; o[d + 3] += pj * vv.w; } }
        }
    }
    {   const float rl = 1.0f / l; float ss = 0.f;
#pragma unroll
        for (int d = 0; d < 32; ++d) { const float y = o[d] * rl; const float oth = __shfl_xor(y, 4); o[d] = y - lam * oth; ss += o[d] * o[d]; }
        ss += __shfl_xor(ss, 1); ss += __shfl_xor(ss, 2);
        const float rs = (1.0f / sqrtf(ss * (1.f / 128.f) + LN_EPS)) * omli;
        if (m == 0) {
            bf16* yp = P + rowq * PP + PC_Q + h * 128 + dq * 32; const float* gp = subg + dq * 32;
#pragma unroll
            for (int i = 0; i < 4; ++i) { u32x4 w;
                w.x = pk2(o[8 * i] * rs * gp[8 * i], o[8 * i + 1] * rs * gp[8 * i + 1]); w.y = pk2(o[8 * i + 2] * rs * gp[8 * i + 2], o[8 * i + 3] * rs * gp[8 * i + 3]);
                w.z = pk2(o[8 * i + 4] * rs * gp[8 * i + 4], o[8 * i + 5] * rs * gp[8 * i + 5]); w.w = pk2(o[8 * i + 6] * rs * gp[8 * i + 6], o[8 * i + 7] * rs * gp[8 * i + 7]);
                *(u32x4*)(yp + 8 * i) = w; }
        }
    }
    __syncthreads();
}

#include <hip/hip_bf16.h>
#include <cmath>
namespace attn_body {
using bf16=__hip_bfloat16;
using bf16x8=__attribute__((ext_vector_type(8)))short;
using s16x4=__attribute__((ext_vector_type(4)))short;
using f32x16=__attribute__((ext_vector_type(16)))float;
using u32x4=__attribute__((ext_vector_type(4)))unsigned;
constexpr int SEQ=16384,D=64;
constexpr int NW=8,QBLK=32,QB=QBLK*NW,KVBLK=64,NQB=SEQ/QB;
constexpr int PQ=2304,PO=1024,ATTN_UNIT_ROWS=QB;
__device__ __forceinline__ int crow(int r,int hi){return (r&3)+8*(r>>2)+4*hi;}
#define SBAR() __builtin_amdgcn_sched_barrier(0)
__device__ __forceinline__ void cmask(f32x16&p0,f32x16&p1,int jb,int qrel,int hi){
  const float NEG=-INFINITY; int kb=64*jb+4*hi;
  #pragma unroll
  for(int r=0;r<16;++r){int kv=kb+(r&3)+8*(r>>2); if(kv>qrel)p0[r]=NEG; if(kv+32>qrel)p1[r]=NEG;}
}

constexpr int NSLOT=3, SLOTB=8192;
constexpr int LDS_K=0, LDS_V=NSLOT*SLOTB, LDS_WS=2*NSLOT*SLOTB, LDS_OST=LDS_WS+NW*64*4, LDS_BYTES=LDS_OST+NW*4096;
constexpr float C2=0.125f*1.4426950408889634f;
__device__ __forceinline__ void glds16(const void*gsrc,unsigned lds_dst){unsigned keep;
  asm volatile("s_mov_b32 %0, m0\n\ts_mov_b32 m0, %2\n\ts_nop 0\n\tglobal_load_lds_dwordx4 %1, off\n\ts_mov_b32 m0, %0":"=&s"(keep):"v"(gsrc),"s"(lds_dst):"memory");}
__device__ __forceinline__ float max3f(float a,float b,float c){float r;asm("v_max3_f32 %0, %1, %2, %3":"=v"(r):"v"(a),"v"(b),"v"(c));return r;}
__device__ __forceinline__ float max2f(float a,float b){float r;asm("v_max_f32_e32 %0, %1, %2":"=v"(r):"v"(a),"v"(b));return r;}
__device__ __forceinline__ float fadd_s(float a,float b){float r;asm("v_add_f32_e32 %0, %1, %2":"=v"(r):"v"(a),"v"(b));return r;}
__device__ __forceinline__ float fsub_s(float a,float b){float r;asm("v_sub_f32_e32 %0, %1, %2":"=v"(r):"v"(a),"v"(b));return r;}
__device__ __forceinline__ float fmul_s(float a,float b){float r;asm("v_mul_f32_e32 %0, %1, %2":"=v"(r):"v"(a),"v"(b));return r;}
typedef float f32x2_t __attribute__((ext_vector_type(2))); typedef __bf16 bf16x2_t __attribute__((ext_vector_type(2)));
__device__ __forceinline__ unsigned cvtpk_s(float lo,float hi){f32x2_t v={lo,hi};bf16x2_t b=__builtin_convertvector(v,bf16x2_t);return __builtin_bit_cast(unsigned,b);}
#define WAIT_BAR(N) asm volatile("s_waitcnt vmcnt(" #N ") lgkmcnt(0)\n\ts_barrier":::"memory")

__device__ __forceinline__ void qkt(f32x16&p0,f32x16&p1,const char*Kslot,const bf16x8*qr,const f32x16&negm,int r32,int hi){
  const char*kb=Kslot+hi*1024+r32*16;
  #pragma unroll
  for(int d0=0;d0<4;++d0){
    const bf16x8 b0=*reinterpret_cast<const bf16x8*>(kb+d0*2048);
    const bf16x8 b1=*reinterpret_cast<const bf16x8*>(kb+d0*2048+512);
    if(d0==0){p0=__builtin_amdgcn_mfma_f32_32x32x16_bf16(b0,qr[0],negm,0,0,0);p1=__builtin_amdgcn_mfma_f32_32x32x16_bf16(b1,qr[0],negm,0,0,0);}
    else{p0=__builtin_amdgcn_mfma_f32_32x32x16_bf16(b0,qr[d0],p0,0,0,0);p1=__builtin_amdgcn_mfma_f32_32x32x16_bf16(b1,qr[d0],p1,0,0,0);}}
}
typedef __attribute__((address_space(3))) const char* lds_cptr;
typedef short v4i16_t __attribute__((ext_vector_type(4)));
__device__ __forceinline__ void kload8(bf16x8*kf,lds_cptr kp){
  kf[0]=*(const __attribute__((address_space(3))) bf16x8*)(kp);      kf[1]=*(const __attribute__((address_space(3))) bf16x8*)(kp+512);
  kf[2]=*(const __attribute__((address_space(3))) bf16x8*)(kp+2048); kf[3]=*(const __attribute__((address_space(3))) bf16x8*)(kp+2560);
  kf[4]=*(const __attribute__((address_space(3))) bf16x8*)(kp+4096); kf[5]=*(const __attribute__((address_space(3))) bf16x8*)(kp+4608);
  kf[6]=*(const __attribute__((address_space(3))) bf16x8*)(kp+6144); kf[7]=*(const __attribute__((address_space(3))) bf16x8*)(kp+6656);
}
__device__ __forceinline__ void kload2(bf16x8*kf,lds_cptr kp,int j){ kf[2*j]=*(const __attribute__((address_space(3))) bf16x8*)(kp+j*2048); kf[2*j+1]=*(const __attribute__((address_space(3))) bf16x8*)(kp+j*2048+512); }
__device__ __forceinline__ s16x4 vtr(lds_cptr p){ return __builtin_bit_cast(s16x4,__builtin_amdgcn_ds_read_tr16_b64_v4i16((__attribute__((address_space(3))) v4i16_t*)p)); }
__device__ __forceinline__ float rowmax(const f32x16&p0,const f32x16&p1){
  float a=max3f(p0[0],p0[1],p1[0]),b=max3f(p0[2],p0[3],p1[1]);a=max3f(a,p1[2],p1[3]);
  #pragma unroll
  for(int r=4;r<16;r+=4){a=max3f(a,p0[r],p0[r+1]);b=max3f(b,p0[r+2],p0[r+3]);a=max3f(a,p1[r],p1[r+1]);b=max3f(b,p1[r+2],p1[r+3]);}
  const float m=max2f(a,b);
  auto rr=__builtin_amdgcn_permlane32_swap(__float_as_uint(m),__float_as_uint(m),false,false);
  return max2f(__uint_as_float(rr[0]),__uint_as_float(rr[1]));
}
__device__ __forceinline__ void pv(f32x16*o,int vb,bf16x8 pa0,bf16x8 pa1,bf16x8 pa2,bf16x8 pa3){
  #pragma unroll
  for(int d0=0;d0<2;++d0){s16x4 lo[4],hi[4];
    #pragma unroll
    for(int ks=0;ks<4;++ks){
      asm volatile("ds_read_b64_tr_b16 %0,%1 offset:%c2":"=&v"(lo[ks]):"v"(vb),"i"(d0*4096+ks*1024):"memory");
      asm volatile("ds_read_b64_tr_b16 %0,%1 offset:%c2":"=&v"(hi[ks]):"v"(vb),"i"(d0*4096+ks*1024+512):"memory");}
    asm volatile("s_waitcnt lgkmcnt(0)":::"memory");SBAR();
    #define PK(k) (bf16x8){lo[k][0],lo[k][1],lo[k][2],lo[k][3],hi[k][0],hi[k][1],hi[k][2],hi[k][3]}
    o[d0]=__builtin_amdgcn_mfma_f32_32x32x16_bf16(pa0,PK(0),o[d0],0,0,0);
    o[d0]=__builtin_amdgcn_mfma_f32_32x32x16_bf16(pa1,PK(1),o[d0],0,0,0);
    o[d0]=__builtin_amdgcn_mfma_f32_32x32x16_bf16(pa2,PK(2),o[d0],0,0,0);
    o[d0]=__builtin_amdgcn_mfma_f32_32x32x16_bf16(pa3,PK(3),o[d0],0,0,0);
    #undef PK
  }
}

#ifndef ATTN_STORE16
#define ATTN_STORE16(p,v) (*(u32x4*)(p)=(v))
#endif
template<int THRL> __device__ __forceinline__ void attn_unit(int b,int qb,const bf16*Q,const bf16*__restrict__ K,const bf16*__restrict__ V,bf16*O,const __attribute__((address_space(3))) float*xtab,char*shm){
  int tid=threadIdx.x; asm volatile("":"+v"(tid)); asm volatile("":"+s"(qb)); asm volatile("":"+s"(b));
  const int lane=tid&63,r32=lane&31,hi=lane>>5; const int wid=__builtin_amdgcn_readfirstlane(tid>>6);
  const long rowbase=(long)b*SEQ; const int q0=qb*QB;
  const bf16*Qw=Q+(rowbase+q0+wid*QBLK)*PQ;
  const bf16*Kh=K+rowbase*PQ,*Vh=V+rowbase*PQ;
  const unsigned lds0=(unsigned)(uintptr_t)shm;
  float*wsf=(float*)(shm+LDS_WS)+wid*64;
  const bf16*ksrc=Kh+(long)lane*PQ+wid*8;
  const bf16*vsrc=Vh+(long)(16*(wid&3)+(lane>>2))*PQ+(wid>>2)*32+(lane&3)*8;
  const unsigned kdst=lds0+LDS_K+wid*1024, vdst=lds0+LDS_V+wid*1024;
  #define DMA_K(t,slot) glds16(ksrc+(long)(t)*KVBLK*PQ,(unsigned)__builtin_amdgcn_readfirstlane(kdst+(slot)))
  #define DMA_V(t,slot) glds16(vsrc+(long)(t)*KVBLK*PQ,(unsigned)__builtin_amdgcn_readfirstlane(vdst+(slot)))
  const int vb0=(int)(lds0+LDS_V)+((lane>>4)&1)*32+(lane&3)*8+(4*hi+((lane&15)>>2))*64;
  const char*Kbase=shm+LDS_K; bf16x8 kf[8];
  const lds_cptr shm3=(lds_cptr)shm; const lds_cptr kp0=shm3+LDS_K+hi*1024+r32*16; const lds_cptr vp0=shm3+LDS_V+((lane>>4)&1)*32+(lane&3)*8+(4*hi+((lane&15)>>2))*64;
  const int NT=(q0+QB)/KVBLK;
  DMA_K(0,0);DMA_V(0,0);DMA_K(1,SLOTB);
  bf16x8 qr[4];
  #pragma unroll
  for(int d0=0;d0<4;++d0)qr[d0]=*reinterpret_cast<const bf16x8*>(&Qw[(long)r32*PQ+d0*16+hi*8]);
  float mhat=0.f,l_reg=0.f;f32x16 o[2];o[0]=f32x16{};o[1]=f32x16{};f32x16 negm=f32x16{};asm volatile("":"+v"(negm));
  const int qrel=wid*QBLK+r32;
  #define CMASK(P0,P1,t) do{int jb_=(t)-(NT-4); if(jb_>=0)cmask(P0,P1,jb_,qrel,hi);}while(0)
  #define CBIAS_ON(P0,P1,t) do{ if((t)>=NT-6){ const __attribute__((address_space(3))) float*tb_=xtab+(q0+qrel-64*(t)-4*hi+(256-59)); \
      _Pragma("unroll") for(int g_=0;g_<4;++g_){ float b0_[4],b1_[4]; \
        _Pragma("unroll") for(int i_=0;i_<4;++i_){ b0_[i_]=tb_[59-(i_+8*g_)]; b1_[i_]=tb_[27-(i_+8*g_)]; } \
        _Pragma("unroll") for(int i_=0;i_<4;++i_){ P0[4*g_+i_]=fadd_s(P0[4*g_+i_],b0_[i_]); P1[4*g_+i_]=fadd_s(P1[4*g_+i_],b1_[i_]); } \
        asm volatile("":"+v"(P0),"+v"(P1)); SBAR(); } } }while(0)
  #define CBIAS(P0,P1,t) CBIAS_ON(P0,P1,t)
  bool resc=false;
  #define START(P0,P1) do{ const float rm=rowmax(P0,P1); resc=false; \
    { const float dl=rm; mhat=fadd_s(mhat,dl); \
      _Pragma("unroll") for(int r=0;r<16;++r){P0[r]=fsub_s(P0[r],dl);P1[r]=fsub_s(P1[r],dl);} \
      _Pragma("unroll") for(int r=0;r<16;++r)negm[r]=-mhat; asm volatile("":"+v"(negm)); } \
    _Pragma("unroll") for(int r=0;r<16;++r)P0[r]=__builtin_amdgcn_exp2f(P0[r]); }while(0)
  #define RESC() do{ if(resc){ asm volatile("s_waitcnt lgkmcnt(0)":::"memory"); \
      _Pragma("unroll") for(int d_=0;d_<2;++d_) _Pragma("unroll") for(int r=0;r<16;++r)o[d_][r]*=wsf[crow(r,hi)]; } }while(0)
  f32x16 pA0,pA1,pB0,pB1;
  int sl_prev=0,sl_cur=0,sl_next=SLOTB;
  #define ROT() do{sl_prev=sl_cur;sl_cur=sl_next;sl_next=(sl_next==(NSLOT-1)*SLOTB)?0:sl_next+SLOTB;}while(0)
  DMA_K(2,2*SLOTB);
  WAIT_BAR(3);
  qkt(pA0,pA1,Kbase,qr,negm,r32,hi);asm volatile("s_nop 15\n\ts_nop 7":"+v"(pA0),"+v"(pA1));CMASK(pA0,pA1,0);CBIAS(pA0,pA1,0);
  START(pA0,pA1);
  _Pragma("unroll") for(int r=0;r<16;++r)pA1[r]=__builtin_amdgcn_exp2f(pA1[r]);
  WAIT_BAR(0);
  DMA_K(3,0);DMA_V(1,SLOTB);
  ROT();
  kload8(kf,kp0+sl_cur);
  WAIT_BAR(2);
  s16x4 vlo[8],vhi[8]; u32x4 pw0,pw1,pw2,pw3;
  #define PKW(P,B) cvtpk_s(P[B],P[B+1])
  #define PAF(k) __builtin_bit_cast(bf16x8,pw##k)
  #define VFR(i) (bf16x8){vlo[i][0],vlo[i][1],vlo[i][2],vlo[i][3],vhi[i][0],vhi[i][1],vhi[i][2],vhi[i][3]}
  #define PIN(x) asm volatile("":"+v"(x))
  #define MX3(a,b,c) __builtin_fmaxf(__builtin_fmaxf((a),(b)),(c))
  #define GAPA(MF,A0,A1,A2,A3,W0,W1,PW) do{ MF; sacc+=A0; sacc+=A1; sacc+=A2; sacc+=A3; PIN(sacc); W0; W1; PIN(PW); SBAR(); }while(0)
  #define EX(v) __builtin_amdgcn_exp2f(v)
  #define GAPB(MF,X,B) do{ MF; X[B]=EX(X[B]); X[B+1]=EX(X[B+1]); X[B+2]=EX(X[B+2]); X[B+3]=EX(X[B+3]); PIN(X); SBAR(); }while(0)
  #define VRD(i) do{ vlo[i]=vtr(vp_+(((i)>>2)*4096+((i)&3)*1024)); vhi[i]=vtr(vp_+(((i)>>2)*4096+((i)&3)*1024+512)); }while(0)
  #define KRD(G,j) do{ if(G){ kload2(kf,kp0+sl_next,j); SBAR(); } }while(0)
  #define STEP(C0,C1,P0,P1,t,GK,GV,GL) do{ SBAR(); \
    const lds_cptr vp_=vp0+sl_prev; \
    VRD(0); SBAR(); float sacc=(P0[0]+P0[1]); \
    GAPA(C0=__builtin_amdgcn_mfma_f32_32x32x16_bf16(kf[0],qr[0],negm,0,0,0), P0[2],P0[3],P0[4],P0[5],     pw0[0]=PKW(P0,0), pw0[1]=PKW(P0,2), pw0); \
    VRD(4); SBAR(); GAPA(C1=__builtin_amdgcn_mfma_f32_32x32x16_bf16(kf[1],qr[0],negm,0,0,0), P0[6],P0[7],P0[8],P0[9],     pw0[2]=PKW(P0,4), pw0[3]=PKW(P0,6), pw0); \
    VRD(1); SBAR(); GAPA(C0=__builtin_amdgcn_mfma_f32_32x32x16_bf16(kf[2],qr[1],C0,0,0,0),   P0[10],P0[11],P0[12],P0[13], pw1[0]=PKW(P0,8), pw1[1]=PKW(P0,10), pw1); \
    VRD(5); SBAR(); GAPA(C1=__builtin_amdgcn_mfma_f32_32x32x16_bf16(kf[3],qr[1],C1,0,0,0),   P0[14],P0[15],P1[0],P1[1],   pw1[2]=PKW(P0,12),pw1[3]=PKW(P0,14), pw1); \
    VRD(2); SBAR(); GAPA(C0=__builtin_amdgcn_mfma_f32_32x32x16_bf16(kf[4],qr[2],C0,0,0,0),   P1[2],P1[3],P1[4],P1[5],     pw2[0]=PKW(P1,0), pw2[1]=PKW(P1,2), pw2); \
    VRD(6); SBAR(); GAPA(C1=__builtin_amdgcn_mfma_f32_32x32x16_bf16(kf[5],qr[2],C1,0,0,0),   P1[6],P1[7],P1[8],P1[9],     pw2[2]=PKW(P1,4), pw2[3]=PKW(P1,6), pw2); \
    VRD(3); SBAR(); GAPA(C0=__builtin_amdgcn_mfma_f32_32x32x16_bf16(kf[6],qr[3],C0,0,0,0),   P1[10],P1[11],P1[12],P1[13], pw3[0]=PKW(P1,8), pw3[1]=PKW(P1,10), pw3); \
    VRD(7); SBAR(); GAPA(C1=__builtin_amdgcn_mfma_f32_32x32x16_bf16(kf[7],qr[3],C1,0,0,0),   P1[14],P1[15],0.f,0.f,       pw3[2]=PKW(P1,12),pw3[3]=PKW(P1,14), pw3); \
    l_reg+=sacc; \
    if(GK){DMA_K((t)+3,sl_cur);} if(GV){DMA_V((t)+1,sl_next);} \
    CMASK(C0,C1,t); CBIAS(C0,C1,t); \
    { float a=MX3(C0[0],C0[1],C1[0]),b=MX3(C0[2],C0[3],C1[1]); a=MX3(a,C1[2],C1[3]); \
      _Pragma("unroll") for(int r=4;r<16;r+=4){a=MX3(a,C0[r],C0[r+1]);b=MX3(b,C0[r+2],C0[r+3]);a=MX3(a,C1[r],C1[r+1]);b=MX3(b,C1[r+2],C1[r+3]);} \
      float rm=__builtin_fmaxf(a,b); { auto rr=__builtin_amdgcn_permlane32_swap(__float_as_uint(rm),__float_as_uint(rm),false,false); rm=__builtin_fmaxf(__uint_as_float(rr[0]),__uint_as_float(rr[1])); } \
      resc=false; \
      if(__builtin_expect(__any(rm>(float)THRL),0)){ const float dl=__builtin_fmaxf(rm,0.f); mhat+=dl; \
        _Pragma("unroll") for(int r=0;r<16;++r){C0[r]-=dl;C1[r]-=dl;} \
        _Pragma("unroll") for(int r=0;r<16;++r)negm[r]=-mhat; asm volatile("":"+v"(negm)); \
        const float f=__builtin_amdgcn_exp2f(-dl); l_reg*=f; if(hi==0)wsf[r32]=f; resc=true; } } \
    SBAR(); \
    GAPB(o[0]=__builtin_amdgcn_mfma_f32_32x32x16_bf16(PAF(0),VFR(0),o[0],0,0,0), C0,0); \
    GAPB(o[1]=__builtin_amdgcn_mfma_f32_32x32x16_bf16(PAF(0),VFR(4),o[1],0,0,0), C0,4); \
    KRD(GL,0); GAPB(o[0]=__builtin_amdgcn_mfma_f32_32x32x16_bf16(PAF(1),VFR(1),o[0],0,0,0), C0,8); \
    KRD(GL,1); GAPB(o[1]=__builtin_amdgcn_mfma_f32_32x32x16_bf16(PAF(1),VFR(5),o[1],0,0,0), C0,12); \
    KRD(GL,2); GAPB(o[0]=__builtin_amdgcn_mfma_f32_32x32x16_bf16(PAF(2),VFR(2),o[0],0,0,0), C1,0); \
    KRD(GL,3); GAPB(o[1]=__builtin_amdgcn_mfma_f32_32x32x16_bf16(PAF(2),VFR(6),o[1],0,0,0), C1,4); \
    GAPB(o[0]=__builtin_amdgcn_mfma_f32_32x32x16_bf16(PAF(3),VFR(3),o[0],0,0,0), C1,8); \
    GAPB(o[1]=__builtin_amdgcn_mfma_f32_32x32x16_bf16(PAF(3),VFR(7),o[1],0,0,0), C1,12); \
    }while(0)
  int t=1;
  #undef CMASK
  #undef CBIAS
  #define CMASK(P0,P1,t) do{}while(0)
  #define CBIAS(P0,P1,t) do{}while(0)
  for(;t+7<NT;t+=2){
    STEP(pB0,pB1,pA0,pA1,t,true,true,true);     WAIT_BAR(2); RESC(); ROT();
    STEP(pA0,pA1,pB0,pB1,t+1,true,true,true);   WAIT_BAR(2); RESC(); ROT();
  }
  #undef CMASK
  #undef CBIAS
  #define CMASK(P0,P1,t) do{int jb_=(t)-(NT-4); if(jb_>=0)cmask(P0,P1,jb_,qrel,hi);}while(0)
  #define CBIAS(P0,P1,t) CBIAS_ON(P0,P1,t)
  #define ENDW(tt) do{ if((tt)+3<NT){WAIT_BAR(2);} else if((tt)+2<NT){WAIT_BAR(1);} else {WAIT_BAR(0);} }while(0)
  for(;t+1<NT;t+=2){
    STEP(pB0,pB1,pA0,pA1,t,(t+3<NT),(t+1<NT),(t+1<NT));       ENDW(t);   RESC(); ROT();
    STEP(pA0,pA1,pB0,pB1,t+1,(t+4<NT),(t+2<NT),(t+2<NT));     ENDW(t+1); RESC(); ROT();
  }
  STEP(pB0,pB1,pA0,pA1,NT-1,false,false,false); RESC();
  { float sacc=pB0[0]+pB0[1]; _Pragma("unroll") for(int r=2;r<16;++r)sacc+=pB0[r]; _Pragma("unroll") for(int r=0;r<16;++r)sacc+=pB1[r]; l_reg+=sacc;
    pw0=(u32x4){PKW(pB0,0),PKW(pB0,2),PKW(pB0,4),PKW(pB0,6)};pw1=(u32x4){PKW(pB0,8),PKW(pB0,10),PKW(pB0,12),PKW(pB0,14)};pw2=(u32x4){PKW(pB1,0),PKW(pB1,2),PKW(pB1,4),PKW(pB1,6)};pw3=(u32x4){PKW(pB1,8),PKW(pB1,10),PKW(pB1,12),PKW(pB1,14)};
    SBAR(); pv(o,vb0+sl_cur,PAF(0),PAF(1),PAF(2),PAF(3)); }
  #undef PKW
  #undef PAF
  #undef VFR
  #undef PIN
  #undef MX3
  #undef GAPA
  #undef GAPB
  #undef EX
  #undef VRD
  #undef KRD
  #undef STEP
  #undef ENDW
  {auto rr=__builtin_amdgcn_permlane32_swap(__float_as_uint(l_reg),__float_as_uint(l_reg),false,false);l_reg=__uint_as_float(rr[0])+__uint_as_float(rr[1]);}
  if(hi==0)wsf[32+r32]=l_reg;asm volatile("s_waitcnt lgkmcnt(0)":::"memory");
  float rli[16];
  #pragma unroll
  for(int r=0;r<16;++r)rli[r]=__builtin_amdgcn_rcpf(wsf[32+crow(r,hi)]);
  bf16*Ow=O+(rowbase+q0+wid*QBLK)*PO;
  { bf16*stg=(bf16*)(shm+LDS_OST)+wid*2048;
    #pragma unroll
    for(int r=0;r<16;++r){const int orow=crow(r,hi);
      #pragma unroll
      for(int d0=0;d0<2;++d0)stg[orow*64+d0*32+r32]=__float2bfloat16(o[d0][r]*rli[r]);}
    asm volatile("s_waitcnt lgkmcnt(0)":::"memory");
    #pragma unroll
    for(int i=0;i<4;++i){const int row=i*8+(lane>>3),ch=lane&7; const u32x4 v=*(const u32x4*)(stg+row*64+ch*8); ATTN_STORE16(Ow+(long)row*PO+ch*8,v);} }
  asm volatile("s_waitcnt lgkmcnt(0)\n\ts_barrier":::"memory");
  #undef DMA_K
  #undef DMA_V
  #undef CMASK
  #undef CBIAS
  #undef CBIAS_ON
  #undef START
  #undef RESC
  #undef ROT
}

constexpr int VSLOT=16384, NSLOTV=4, L2_K=0, L2_V=NSLOT*SLOTB, L2_WS=L2_V+NSLOTV*VSLOT, L2_OST=L2_WS+NW*64*4, L2_BYTES=L2_OST+NW*4096;
template<int THRL> __device__ __forceinline__ void attn_unit2(int b,int qb,const bf16*Q,const bf16*__restrict__ K,const bf16*__restrict__ V,bf16*O,const __attribute__((address_space(3))) float*xtab,char*shm){
  int tid=threadIdx.x; asm volatile("":"+v"(tid)); asm volatile("":"+s"(qb)); asm volatile("":"+s"(b));
  const int lane=tid&63,r32=lane&31,hi=lane>>5; const int wid=__builtin_amdgcn_readfirstlane(tid>>6);
  const long rowbase=(long)b*SEQ; const int q0=qb*QB;
  const bf16*Qw=Q+(rowbase+q0+wid*QBLK)*PQ;
  const bf16*Kh=K+rowbase*PQ,*Vh=V+rowbase*PQ;
  const unsigned lds0=(unsigned)(uintptr_t)shm;
  float*wsf=(float*)(shm+L2_WS)+wid*64;
  const bf16*ksrc=Kh+(long)lane*PQ+wid*8;
  const bf16*vsrc=Vh+(long)(16*(wid&3)+(lane>>2))*PQ+(wid>>2)*32+(lane&3)*8;
  const unsigned kdst=lds0+L2_K+wid*1024, vdst=lds0+L2_V+wid*1024;
  #define DMA_K(t,slot) glds16(ksrc+(long)(t)*KVBLK*PQ,(unsigned)__builtin_amdgcn_readfirstlane(kdst+(slot)))
  #define DMA_V(t,voff) do{ glds16(vsrc+(long)(t)*KVBLK*PQ,(unsigned)__builtin_amdgcn_readfirstlane(vdst+(voff))); glds16(vsrc+64+(long)(t)*KVBLK*PQ,(unsigned)__builtin_amdgcn_readfirstlane(vdst+(voff)+8192)); }while(0)
  const int vb0=(int)(lds0+L2_V)+((lane>>4)&1)*32+(lane&3)*8+(4*hi+((lane&15)>>2))*64;
  const char*Kbase=shm+L2_K; bf16x8 kf[8];
  const lds_cptr shm3=(lds_cptr)shm; const lds_cptr kp0=shm3+L2_K+hi*1024+r32*16; const lds_cptr vp0=shm3+L2_V+((lane>>4)&1)*32+(lane&3)*8+(4*hi+((lane&15)>>2))*64;
  const int NT=(q0+QB)/KVBLK;
  DMA_K(0,0);DMA_V(0,0);DMA_K(1,SLOTB);
  bf16x8 qr[4];
  #pragma unroll
  for(int d0=0;d0<4;++d0)qr[d0]=__builtin_nontemporal_load(reinterpret_cast<const bf16x8*>(&Qw[(long)r32*PQ+d0*16+hi*8]));
  float mhat=0.f,l_reg=0.f;f32x16 o[4];o[0]=f32x16{};o[1]=f32x16{};o[2]=f32x16{};o[3]=f32x16{};
  const int qrel=wid*QBLK+r32;
  #define CMASK(P0,P1,t) do{int jb_=(t)-(NT-4); if(jb_>=0)cmask(P0,P1,jb_,qrel,hi);}while(0)
  #define CBIAS_ON(P0,P1,t) do{ if((t)>=NT-6){ const __attribute__((address_space(3))) float*tb_=xtab+(q0+qrel-64*(t)-4*hi+(256-59)); \
      _Pragma("unroll") for(int g_=0;g_<4;++g_){ float b0_[4],b1_[4]; \
        _Pragma("unroll") for(int i_=0;i_<4;++i_){ b0_[i_]=tb_[59-(i_+8*g_)]; b1_[i_]=tb_[27-(i_+8*g_)]; } \
        _Pragma("unroll") for(int i_=0;i_<4;++i_){ P0[4*g_+i_]=fadd_s(P0[4*g_+i_],b0_[i_]); P1[4*g_+i_]=fadd_s(P1[4*g_+i_],b1_[i_]); } \
        asm volatile("":"+v"(P0),"+v"(P1)); SBAR(); } } }while(0)
  #define CBIAS(P0,P1,t) CBIAS_ON(P0,P1,t)
  bool resc=false;
  #define START(P0,P1) do{ const float rm=rowmax(P0,P1); resc=false; \
    { const float dl=rm; mhat=fadd_s(mhat,dl); \
      _Pragma("unroll") for(int r=0;r<16;++r){P0[r]=fsub_s(P0[r],dl);P1[r]=fsub_s(P1[r],dl);} \
      } \
    _Pragma("unroll") for(int r=0;r<16;++r)P0[r]=__builtin_amdgcn_exp2f(P0[r]); }while(0)
  #define RESC() do{ if(resc){ asm volatile("s_waitcnt lgkmcnt(0)":::"memory"); \
      _Pragma("unroll") for(int r=0;r<16;++r){ const float f_=wsf[crow(r,hi)]; _Pragma("unroll") for(int d_=0;d_<4;++d_) o[d_][r]=fmul_s(o[d_][r],f_); } } }while(0)
  f32x16 c0,c1; f32x16 negm;
  int sl_prev=0,sl_cur=0,sl_next=SLOTB; int vs_prev=0,vs_dma=3*VSLOT;
  #define ROT() do{sl_prev=sl_cur;sl_cur=sl_next;sl_next=(sl_next==(NSLOT-1)*SLOTB)?0:sl_next+SLOTB; vs_prev=(vs_prev+VSLOT)&(NSLOTV*VSLOT-1); vs_dma=(vs_dma+VSLOT)&(NSLOTV*VSLOT-1);}while(0)
  DMA_K(2,2*SLOTB);DMA_V(1,VSLOT);
  WAIT_BAR(6);
  s16x4 vlo[8],vhi[8]; u32x4 pw0,pw1,pw2,pw3;
  #define PKW(P,B) cvtpk_s(P[B],P[B+1])
  #define PAF(k) __builtin_bit_cast(bf16x8,pw##k)
  { const f32x16 zero16=f32x16{}; qkt(c0,c1,Kbase,qr,zero16,r32,hi); }asm volatile("s_nop 15\n\ts_nop 7":"+v"(c0),"+v"(c1));CMASK(c0,c1,0);CBIAS(c0,c1,0);
  START(c0,c1);
  { const float nm_=-mhat; _Pragma("unroll") for(int r=0;r<16;++r)negm[r]=nm_; }
  _Pragma("unroll") for(int r=0;r<16;++r)c1[r]=__builtin_amdgcn_exp2f(c1[r]);
  { float sacc=c0[0]+c0[1]; _Pragma("unroll") for(int r=2;r<16;++r)sacc+=c0[r]; _Pragma("unroll") for(int r=0;r<16;++r)sacc+=c1[r]; l_reg+=sacc;
    pw0=(u32x4){PKW(c0,0),PKW(c0,2),PKW(c0,4),PKW(c0,6)};pw1=(u32x4){PKW(c0,8),PKW(c0,10),PKW(c0,12),PKW(c0,14)};pw2=(u32x4){PKW(c1,0),PKW(c1,2),PKW(c1,4),PKW(c1,6)};pw3=(u32x4){PKW(c1,8),PKW(c1,10),PKW(c1,12),PKW(c1,14)}; }
  WAIT_BAR(0);
  DMA_K(3,0);DMA_V(2,2*VSLOT);
  sl_prev=sl_cur;sl_cur=sl_next;sl_next=2*SLOTB;
  kload8(kf,kp0+sl_cur);
  WAIT_BAR(3);
  #define VFR(i) (bf16x8){vlo[i][0],vlo[i][1],vlo[i][2],vlo[i][3],vhi[i][0],vhi[i][1],vhi[i][2],vhi[i][3]}
  #define PIN(x) asm volatile("":"+v"(x))
  #define MX3(a,b,c) __builtin_fmaxf(__builtin_fmaxf((a),(b)),(c))
  #define MFM(a,b,c) __builtin_amdgcn_mfma_f32_32x32x16_bf16(a,b,c,0,0,0)
  #define GAPA(MF) do{ MF; SBAR(); }while(0)
  #define EX(v) __builtin_amdgcn_exp2f(v)
  #define GAPB(MF,X,B) do{ MF; X[B]=EX(X[B]); X[B+1]=EX(X[B+1]); X[B+2]=EX(X[B+2]); X[B+3]=EX(X[B+3]); PIN(X); SBAR(); }while(0)
  #define GAPS(MF,A0,A1,A2,A3) do{ MF; sacc+=A0; sacc+=A1; sacc+=A2; sacc+=A3; PIN(sacc); SBAR(); }while(0)
  #define GAPC(MF,A0,A1,A2,A3,W0,W1,PW) do{ MF; sacc+=A0; sacc+=A1; sacc+=A2; sacc+=A3; PIN(sacc); W0; W1; PIN(PW); SBAR(); }while(0)
  #define VRD(i) do{ vlo[i]=vtr(vp_+(((i)>>2)*4096+((i)&3)*1024)); vhi[i]=vtr(vp_+(((i)>>2)*4096+((i)&3)*1024+512)); }while(0)
  #define VRD2(i) do{ vlo[i]=vtr(vp_+(8192+((i)>>2)*4096+((i)&3)*1024)); vhi[i]=vtr(vp_+(8192+((i)>>2)*4096+((i)&3)*1024+512)); }while(0)
  #define KRD(G,j) do{ if(G){ kload2(kf,kp0+sl_next,j); SBAR(); } }while(0)
  #define STEP2(t,GK,GV,GL) do{ SBAR(); \
    const lds_cptr vp_=vp0+vs_prev; \
    VRD(0); SBAR(); GAPA(c0=MFM(kf[0],qr[0],negm)); \
    VRD(4); SBAR(); GAPA(c1=MFM(kf[1],qr[0],negm)); \
    VRD(1); SBAR(); GAPA(c0=MFM(kf[2],qr[1],c0)); \
    VRD(5); SBAR(); GAPA(c1=MFM(kf[3],qr[1],c1)); \
    VRD(2); SBAR(); GAPA(c0=MFM(kf[4],qr[2],c0)); \
    VRD(6); SBAR(); GAPA(c1=MFM(kf[5],qr[2],c1)); \
    VRD(3); SBAR(); GAPA(c0=MFM(kf[6],qr[3],c0)); \
    VRD(7); SBAR(); GAPA(c1=MFM(kf[7],qr[3],c1)); \
    if(GK){DMA_K((t)+3,sl_cur);} if(GV){DMA_V((t)+2,vs_dma);} \
    CMASK(c0,c1,t); CBIAS(c0,c1,t); \
    { float a=MX3(c0[0],c0[1],c1[0]),b=MX3(c0[2],c0[3],c1[1]); a=MX3(a,c1[2],c1[3]); \
      _Pragma("unroll") for(int r=4;r<16;r+=4){a=MX3(a,c0[r],c0[r+1]);b=MX3(b,c0[r+2],c0[r+3]);a=MX3(a,c1[r],c1[r+1]);b=MX3(b,c1[r+2],c1[r+3]);} \
      float rm=__builtin_fmaxf(a,b); { auto rr=__builtin_amdgcn_permlane32_swap(__float_as_uint(rm),__float_as_uint(rm),false,false); rm=__builtin_fmaxf(__uint_as_float(rr[0]),__uint_as_float(rr[1])); } \
      resc=false; \
      if(__builtin_expect(__any(rm>(float)THRL),0)){ const float dl=__builtin_fmaxf(rm,0.f); mhat+=dl; { const float nm_=-mhat; _Pragma("unroll") for(int r=0;r<16;++r)negm[r]=nm_; } \
        _Pragma("unroll") for(int r=0;r<16;++r){c0[r]-=dl;c1[r]-=dl;} \
        const float f=__builtin_amdgcn_exp2f(-dl); l_reg*=f; if(hi==0)wsf[r32]=f; resc=true; } } \
    SBAR(); \
    GAPB(o[0]=MFM(PAF(0),VFR(0),o[0]), c0,0); \
    VRD2(0); SBAR(); GAPB(o[1]=MFM(PAF(0),VFR(4),o[1]), c0,4); \
    VRD2(4); SBAR(); GAPB(o[0]=MFM(PAF(1),VFR(1),o[0]), c0,8); \
    VRD2(1); SBAR(); GAPB(o[1]=MFM(PAF(1),VFR(5),o[1]), c0,12); \
    VRD2(5); SBAR(); GAPB(o[0]=MFM(PAF(2),VFR(2),o[0]), c1,0); \
    VRD2(2); SBAR(); GAPB(o[1]=MFM(PAF(2),VFR(6),o[1]), c1,4); \
    VRD2(6); SBAR(); GAPB(o[0]=MFM(PAF(3),VFR(3),o[0]), c1,8); \
    VRD2(3); SBAR(); GAPB(o[1]=MFM(PAF(3),VFR(7),o[1]), c1,12); \
    float sacc=(c0[0]+c0[1]); \
    VRD2(7); SBAR(); GAPS(o[2]=MFM(PAF(0),VFR(0),o[2]), c0[2],c0[3],c0[4],c0[5]); \
    KRD(GL,0); GAPS(o[3]=MFM(PAF(0),VFR(4),o[3]), c0[6],c0[7],c0[8],c0[9]); \
    KRD(GL,1); GAPC(o[2]=MFM(PAF(1),VFR(1),o[2]), c0[10],c0[11],c0[12],c0[13], pw0[0]=PKW(c0,0), pw0[1]=PKW(c0,2), pw0); \
    KRD(GL,2); GAPC(o[3]=MFM(PAF(1),VFR(5),o[3]), c0[14],c0[15],c1[0],c1[1],   pw0[2]=PKW(c0,4), pw0[3]=PKW(c0,6), pw0); \
    KRD(GL,3); GAPC(o[2]=MFM(PAF(2),VFR(2),o[2]), c1[2],c1[3],c1[4],c1[5],     pw1[0]=PKW(c0,8), pw1[1]=PKW(c0,10), pw1); \
    GAPC(o[3]=MFM(PAF(2),VFR(6),o[3]), c1[6],c1[7],c1[8],c1[9],     pw1[2]=PKW(c0,12),pw1[3]=PKW(c0,14), pw1); \
    GAPC(o[2]=MFM(PAF(3),VFR(3),o[2]), c1[10],c1[11],c1[12],c1[13], pw2[0]=PKW(c1,0), pw2[1]=PKW(c1,2), pw2); \
    GAPC(o[3]=MFM(PAF(3),VFR(7),o[3]), c1[14],c1[15],0.f,0.f,       pw2[2]=PKW(c1,4), pw2[3]=PKW(c1,6), pw2); \
    pw3[0]=PKW(c1,8); pw3[1]=PKW(c1,10); pw3[2]=PKW(c1,12); pw3[3]=PKW(c1,14); PIN(pw3); \
    l_reg+=sacc; \
    }while(0)
  int t=1;
  #undef CMASK
  #undef CBIAS
  #define CMASK(P0,P1,t) do{}while(0)
  #define CBIAS(P0,P1,t) do{}while(0)
  for(;t+7<NT;t+=2){
    STEP2(t,true,true,true);     WAIT_BAR(3); RESC(); ROT();
    STEP2(t+1,true,true,true);   WAIT_BAR(3); RESC(); ROT();
  }
  #undef CMASK
  #undef CBIAS
  #define CMASK(P0,P1,t) do{int jb_=(t)-(NT-4); if(jb_>=0)cmask(P0,P1,jb_,qrel,hi);}while(0)
  #define CBIAS(P0,P1,t) CBIAS_ON(P0,P1,t)
  #define ENDW(tt) do{ if((tt)+3<NT){WAIT_BAR(3);} else if((tt)+2<NT){WAIT_BAR(2);} else {WAIT_BAR(0);} }while(0)
  for(;t+1<NT;t+=2){
    STEP2(t,(t+3<NT),(t+2<NT),(t+1<NT));       ENDW(t);   RESC(); ROT();
    STEP2(t+1,(t+4<NT),(t+3<NT),(t+2<NT));     ENDW(t+1); RESC(); ROT();
  }
  STEP2(NT-1,false,false,false); RESC();
  { const int vlast=(vs_prev+VSLOT)&(NSLOTV*VSLOT-1);
    SBAR(); pv(o,vb0+vlast,PAF(0),PAF(1),PAF(2),PAF(3)); pv(o+2,vb0+vlast+8192,PAF(0),PAF(1),PAF(2),PAF(3)); }
  #undef PKW
  #undef PAF
  #undef VFR
  #undef PIN
  #undef MX3
  #undef MFM
  #undef GAPA
  #undef GAPB
  #undef GAPC
  #undef GAPS
  #undef EX
  #undef VRD
  #undef VRD2
  #undef KRD
  #undef STEP2
  #undef ENDW
  {auto rr=__builtin_amdgcn_permlane32_swap(__float_as_uint(l_reg),__float_as_uint(l_reg),false,false);l_reg=__uint_as_float(rr[0])+__uint_as_float(rr[1]);}
  if(hi==0)wsf[32+r32]=l_reg;asm volatile("s_waitcnt lgkmcnt(0)":::"memory");
  float rli[16];
  #pragma unroll
  for(int r=0;r<16;++r)rli[r]=__builtin_amdgcn_rcpf(wsf[32+crow(r,hi)]);
  bf16*Ow=O+(rowbase+q0+wid*QBLK)*PO;
  { bf16*stg=(bf16*)(shm+L2_OST)+wid*2048;
    #pragma unroll
    for(int ph=0;ph<2;++ph){
      #pragma unroll
      for(int r=0;r<16;++r){const int orow=crow(r,hi);
        #pragma unroll
        for(int d0=0;d0<2;++d0)stg[orow*64+d0*32+r32]=__float2bfloat16(o[2*ph+d0][r]*rli[r]);}
      asm volatile("s_waitcnt lgkmcnt(0)":::"memory");
      #pragma unroll
      for(int i=0;i<4;++i){const int row=i*8+(lane>>3),ch=lane&7; const u32x4 v=*(const u32x4*)(stg+row*64+ch*8); ATTN_STORE16(Ow+(long)row*PO+ph*64+ch*8,v);}
      asm volatile("s_waitcnt lgkmcnt(0)":::"memory"); } }
  asm volatile("s_waitcnt lgkmcnt(0)\n\ts_barrier":::"memory");
  #undef DMA_K
  #undef DMA_V
  #undef CMASK
  #undef CBIAS
  #undef CBIAS_ON
  #undef START
  #undef RESC
  #undef ROT
}
constexpr int ATTN_LDS_BYTES=LDS_BYTES;
#undef SBAR
#undef WAIT_BAR
}


__device__ __forceinline__ void diff_combine(bf16* P, const bf16* OS, int b, int h, int qb, float lam, const float* subg, float omli) {
    const int tid = opaque_tid(); const int row = tid >> 1, vh = tid & 1;
    asm volatile("s_waitcnt vmcnt(0)" ::: "memory"); __syncthreads();
    const size_t grow = (size_t)b * SEQ + (size_t)qb * 256 + row;
    const GAS unsigned long long* o0 = (const GAS unsigned long long*)(OS + grow * 1024 + h * 256 + vh * 64);
    const GAS unsigned long long* o1 = (const GAS unsigned long long*)(OS + grow * 1024 + h * 256 + (2 + vh) * 64);
    float y[64]; float ss = 0.f;
#pragma unroll
    for (int i = 0; i < 16; ++i) { const unsigned long long a = __hip_atomic_load(o0 + i, __ATOMIC_RELAXED, __HIP_MEMORY_SCOPE_AGENT), c = __hip_atomic_load(o1 + i, __ATOMIC_RELAXED, __HIP_MEMORY_SCOPE_AGENT);
        const unsigned a0 = (unsigned)a, a1 = (unsigned)(a >> 32), c0 = (unsigned)c, c1 = (unsigned)(c >> 32);
        y[4 * i] = bflo(a0) - lam * bflo(c0); y[4 * i + 1] = bfhi(a0) - lam * bfhi(c0); y[4 * i + 2] = bflo(a1) - lam * bflo(c1); y[4 * i + 3] = bfhi(a1) - lam * bfhi(c1);
        ss += (y[4 * i] * y[4 * i] + y[4 * i + 1] * y[4 * i + 1]) + (y[4 * i + 2] * y[4 * i + 2] + y[4 * i + 3] * y[4 * i + 3]); }
    ss += shx(ss, tid & 63, 1);
    const float rs = (1.0f / sqrtf(ss * (1.f / 128.f) + LN_EPS)) * omli;
    bf16* yp = P + grow * PP + PC_Q + h * 128 + vh * 64; const float* gp = subg + vh * 64;
#pragma unroll
    for (int i = 0; i < 8; ++i) { u32x4 w;
        w.x = pk2(y[8 * i] * rs * gp[8 * i], y[8 * i + 1] * rs * gp[8 * i + 1]); w.y = pk2(y[8 * i + 2] * rs * gp[8 * i + 2], y[8 * i + 3] * rs * gp[8 * i + 3]);
        w.z = pk2(y[8 * i + 4] * rs * gp[8 * i + 4], y[8 * i + 5] * rs * gp[8 * i + 5]); w.w = pk2(y[8 * i + 6] * rs * gp[8 * i + 6], y[8 * i + 7] * rs * gp[8 * i + 7]);
        *(u32x4*)(yp + 8 * i) = w; }
}

template <int MODE>
__device__ __forceinline__ void ln_phase(const Args& a, LAS unsigned char* lds, float* outf, const float* gam, const float* bet, const float* rw) {
    const int tid = opaque_tid(), lane = tid & 63, wave = tid >> 6;
    unsigned char* ws = a.ws;
    bf16* xb = (bf16*)(ws + WS_XB);
    int* tok_e = (int*)(ws + WS_ROUTE); int* tok_off = tok_e + 2 * M; float* tok_g = (float*)(tok_off + 2 * M);
    const bf16* fs = (const bf16*)(ws + WS_ASORT);
    gu32* cur = (gu32*)(ws + WS_CTL) + CW_CUR;
    LAS int* lcnt = (LAS int*)lds;
    LAS int* lbase = lcnt + 8;
    LAS int* lrow = lcnt + 16;
    if (MODE == 1) { if (tid < 16) lcnt[tid] = 0; __syncthreads(); }
    f32x4 gv[4], bv[4];
#pragma unroll
    for (int q = 0; q < 4; ++q) { gv[q] = *(const f32x4*)(gam + 8 * lane + 512 * (q >> 1) + 4 * (q & 1)); bv[q] = *(const f32x4*)(bet + 8 * lane + 512 * (q >> 1) + 4 * (q & 1)); }
    LAS f32x4* rwlA = (LAS f32x4*)(lds + 4096);
    LAS f32x4* rwlB = rwlA + 1024;

    f32x4 rwr[16][2];
    if (MODE == 1) {
#pragma unroll
        for (int q = 0; q < 4; ++q)
#pragma unroll
            for (int i = 0; i < 4; ++i) { const int col = 8 * lane + 512 * (q >> 1) + 4 * (q & 1) + i; rwr[q * 4 + i][0] = *((const f32x4*)rw + 2 * col); rwr[q * 4 + i][1] = *((const f32x4*)rw + 2 * col + 1); } }
    const int row0 = pair_row0(opaque_s((int)blockIdx.x)); const int rowbase = row0 + wave * 16;
    u32x4 nz[4][2], nw1[4][2], nw2[4][2]; float ng1[4], ng2[4];
    int mypos = 0; float myg = 0.f;
    if (MODE == 2) {
        const int ee = tok_e[2 * rowbase + (lane & 31)], oo = tok_off[2 * rowbase + (lane & 31)]; myg = tok_g[2 * rowbase + (lane & 31)];
        int acc = 0, sb = 0;
#pragma unroll
        for (int e = 0; e < 8; ++e) { sb = (ee == e) ? acc : sb; acc += ((int)__hip_atomic_load(cur + 64 * e, __ATOMIC_RELAXED, __HIP_MEMORY_SCOPE_AGENT) + 255) & ~255; }
        mypos = sb + oo; }
#define LN_LOAD(SL, RR) do { const int rr_ = (RR); const int row_ = rowbase + rr_; const u32x4* zr_ = (const u32x4*)(xb + (size_t)row_ * DM) + lane; \
        if (MODE == 2) { nz[SL][0] = __builtin_nontemporal_load(zr_); nz[SL][1] = __builtin_nontemporal_load(zr_ + 64); } else { nz[SL][0] = zr_[0]; nz[SL][1] = zr_[64]; }     \
        if (MODE == 2) { const int p1 = __builtin_amdgcn_readlane(mypos, 2 * rr_), p2 = __builtin_amdgcn_readlane(mypos, 2 * rr_ + 1); \
            ng1[SL] = __builtin_bit_cast(float, __builtin_amdgcn_readlane(__builtin_bit_cast(int, myg), 2 * rr_)); ng2[SL] = __builtin_bit_cast(float, __builtin_amdgcn_readlane(__builtin_bit_cast(int, myg), 2 * rr_ + 1)); \
            const u32x4* f1 = (const u32x4*)(fs + (size_t)p1 * DM) + lane; const u32x4* f2 = (const u32x4*)(fs + (size_t)p2 * DM) + lane; \
            nw1[SL][0] = __builtin_nontemporal_load(f1); nw1[SL][1] = __builtin_nontemporal_load(f1 + 64); nw2[SL][0] = __builtin_nontemporal_load(f2); nw2[SL][1] = __builtin_nontemporal_load(f2 + 64); } } while (0)
#define LN_UNPK_LO(W_) ((f32x4){bflo((W_).x), bfhi((W_).x), bflo((W_).y), bfhi((W_).y)})
#define LN_UNPK_HI(W_) ((f32x4){bflo((W_).z), bfhi((W_).z), bflo((W_).w), bfhi((W_).w)})
    LN_LOAD(0, 0); LN_LOAD(1, 1); LN_LOAD(2, 2);
#pragma unroll 1
    for (int rq = 0; rq < 16; rq += 4) {
#pragma unroll
      for (int u = 0; u < 4; ++u) {
        const int rr = rq + u;
        const int row = rowbase + rr;
        if (rr + 3 < 16) LN_LOAD((u + 3) & 3, rr + 3);
        f32x4 v[4]; float s = 0.f;
#pragma unroll
        for (int j = 0; j < 2; ++j) { v[2 * j] = LN_UNPK_LO(nz[u][j]); v[2 * j + 1] = LN_UNPK_HI(nz[u][j]); }
        if (MODE == 2) {
#pragma unroll
            for (int j = 0; j < 2; ++j) { const u32x4 w1 = nw1[u][j], w2 = nw2[u][j];
                v[2 * j] = v[2 * j] * ALPHA + LN_UNPK_LO(w1) * ng1[u] + LN_UNPK_LO(w2) * ng2[u];
                v[2 * j + 1] = v[2 * j + 1] * ALPHA + LN_UNPK_HI(w1) * ng1[u] + LN_UNPK_HI(w2) * ng2[u]; }
        }
#pragma unroll
        for (int j = 0; j < 4; ++j) s += (v[j].x + v[j].y) + (v[j].z + v[j].w);
        const float mean = wave_sum(s, lane) * (1.f / DM); float s2 = 0.f;
#pragma unroll
        for (int j = 0; j < 4; ++j) { v[j] = v[j] - mean; s2 += (v[j].x * v[j].x + v[j].y * v[j].y) + (v[j].z * v[j].z + v[j].w * v[j].w); }
        const float rstd = 1.f / sqrtf(wave_sum(s2, lane) * (1.f / DM) + LN_EPS);
#pragma unroll
        for (int j = 0; j < 4; ++j) v[j] = v[j] * rstd * gv[j] + bv[j];
        if (MODE != 2) { u32x4* o = (u32x4*)(xb + (size_t)row * DM) + lane; o[0] = pack8(v[0], v[1]); o[64] = pack8(v[2], v[3]); }
        else { f32x4* of = (f32x4*)(outf + (size_t)row * DM + 8 * lane); __builtin_nontemporal_store(v[0], of); __builtin_nontemporal_store(v[1], of + 1); __builtin_nontemporal_store(v[2], of + 128); __builtin_nontemporal_store(v[3], of + 129); }
        if (MODE == 1) {
            float lg[8];
#pragma unroll
            for (int e = 0; e < 8; ++e) lg[e] = 0.f;
#pragma unroll
            for (int q = 0; q < 4; ++q)
#pragma unroll
                for (int i = 0; i < 4; ++i) { const float xv = v[q][i]; const f32x4 r0 = rwr[q * 4 + i][0], r1 = rwr[q * 4 + i][1];
                    lg[0] += xv * r0.x; lg[1] += xv * r0.y; lg[2] += xv * r0.z; lg[3] += xv * r0.w;
                    lg[4] += xv * r1.x; lg[5] += xv * r1.y; lg[6] += xv * r1.z; lg[7] += xv * r1.w; }
#pragma unroll
            for (int e = 0; e < 8; ++e) lg[e] = wave_sum(lg[e], lane);
            int i1 = 0; float v1 = lg[0];
#pragma unroll
            for (int e = 1; e < 8; ++e) if (lg[e] > v1) { v1 = lg[e]; i1 = e; }
            int i2 = -1; float v2 = -INFINITY;
#pragma unroll
            for (int e = 0; e < 8; ++e) if (e != i1 && lg[e] > v2) { v2 = lg[e]; i2 = e; }
            const float ex = __expf(v2 - v1); const float w1 = 1.0f / (1.0f + ex), w2 = ex * w1;
            if (lane == 0) {
                const int k1 = atomicAdd((int*)&lcnt[i1], 1), k2 = atomicAdd((int*)&lcnt[i2], 1);
                lrow[(wave * 16 + rr) * 4 + 0] = i1; lrow[(wave * 16 + rr) * 4 + 1] = i2; lrow[(wave * 16 + rr) * 4 + 2] = k1; lrow[(wave * 16 + rr) * 4 + 3] = k2;
                tok_g[2 * row] = w1; tok_g[2 * row + 1] = w2;
            }
        }
      }
    }
    if (MODE == 1) { asm volatile("s_waitcnt vmcnt(0)" ::: "memory");
#pragma unroll 4
        for (int rr = 0; rr < 16; ++rr) { const int row = rowbase + rr; const u32x4* src = (const u32x4*)(xb + (size_t)row * DM) + lane; u32x2* o8 = (u32x2*)(ws + WS_XB8 + (size_t)row * DM) + lane;
#pragma unroll
            for (int j = 0; j < 2; ++j) { const u32x4 w = src[64 * j];
                o8[64 * j] = (u32x2){pk4f8(bflo(w.x) * F8_SC_Y, bfhi(w.x) * F8_SC_Y, bflo(w.y) * F8_SC_Y, bfhi(w.y) * F8_SC_Y), pk4f8(bflo(w.z) * F8_SC_Y, bfhi(w.z) * F8_SC_Y, bflo(w.w) * F8_SC_Y, bfhi(w.w) * F8_SC_Y)}; } } }
#undef LN_LOAD
#undef LN_UNPK_LO
#undef LN_UNPK_HI
    if (MODE == 1) {
        __syncthreads();
        if (tid < 8) lbase[tid] = (int)__hip_atomic_fetch_add(cur + 64 * tid, (unsigned)lcnt[tid], __ATOMIC_RELAXED, __HIP_MEMORY_SCOPE_AGENT);
        __syncthreads();
        if (tid < 128) { const int row = row0 + tid; const int e1 = lrow[tid * 4], e2 = lrow[tid * 4 + 1];
            const int o1 = lbase[e1] + lrow[tid * 4 + 2], o2 = lbase[e2] + lrow[tid * 4 + 3];
            tok_e[2 * row] = e1; tok_e[2 * row + 1] = e2; tok_off[2 * row] = o1; tok_off[2 * row + 1] = o2;
            int* rowtok = (int*)(ws + WS_ROWTOK); rowtok[e1 * 32768 + o1] = row; rowtok[e2 * 32768 + o2] = row; }
        __syncthreads();
    }
}

template <int l> __device__ __forceinline__ void layer_body(const Args& args, LAS unsigned char* lds, unsigned char* lds_raw, const XcdBarrier& bar) {
#define GRID_BAR() xcd_barrier(bar)
        {   unsigned char* ws = opq(args.ws); const int blk = opaque_s((int)blockIdx.x), G = opaque_s((int)gridDim.x);
            Gemm g{(const bf16*)(ws + WS_XB), (const bf16*)(ws + WS_WIN) + (size_t)l * DIN * DM, DM, DM};
            EpiInProj E{(bf16*)(ws + WS_P)};
            if (l == 0) { StaticOrder S; S.init(M, DIN, G, blk); GEMM_PHASE(lds, g, S, E); }
            else {
                pair_sync((unsigned*)((gu32*)(ws + WS_CTL) + CW_PAIR) + 16 * (3 * 128 + 2 * 64 + quad_id(blk)), bar, 4u);
                QuadOrder S; S.c = blk; S.nn = DIN / 256; GEMM_PHASE(lds, g, S, E); }
        }
        GRID_BAR();
        {
            unsigned char* ws = opq(args.ws); const int blk = opaque_s((int)blockIdx.x), G = opaque_s((int)gridDim.x);
            bf16* P = (bf16*)(ws + WS_P);
            const float lam_init = (l == 0) ? 0.2f : (0.8f - 0.6f * 0.7408182206817179f);
            float lam;
            LAS float* btab = (LAS float*)(lds + RING_BYTES - 2048);
            LAS float* xtab = (LAS float*)(lds + RING_BYTES - 6144);
            {   const int tid = opaque_tid(), lane = tid & 63;
                const float* q1 = args.in[I_LQ1] + l * 64; const float* k1 = args.in[I_LK1] + l * 64; const float* q2 = args.in[I_LQ2] + l * 64; const float* k2 = args.in[I_LK2] + l * 64;
                const float d1 = wave_sum(q1[lane] * k1[lane], lane), d2 = wave_sum(q2[lane] * k2[lane], lane);
                lam = __builtin_bit_cast(float, __builtin_amdgcn_readfirstlane(__builtin_bit_cast(int, __expf(d1) - __expf(d2) + lam_init)));
                __syncthreads();
                const int hh = tid >> 7, d = tid & 127; const float* rb = args.in[I_RELB];
                btab[hh * 128 + d] = (rb[t5_bucket(d) * 4 + hh] - rb[31 * 4 + hh]) * LOG2E;
                __syncthreads();
                {   const int vcu_ = (blk & 7) * (G >> 3) + (blk >> 3); const int h_ = (vcu_ >> 5) & 3;
                    for (int i = tid; i < 640; i += NTHR) { const int dist = i - 256; xtab[i] = (dist >= 0 && dist < 128) ? btab[h_ * 128 + dist] : 0.f; } }
                __syncthreads(); }
#ifdef USE_NAIVE_ATTN
            for (int i = 0; i < 8; ++i) {
                const int L = i * G + blk; const int bh = L & 7, qt = L >> 3;
                nattn_unit(lds, P, bh >> 2, bh & 3, qt, btab + (bh & 3) * 128, lam, args.in[I_SUBG] + l * 128, 1.0f - lam_init);
            }
#else
            {
                const int vcu = (blk & 7) * (G >> 3) + (blk >> 3); const int bh = vcu >> 5, sp = vcu & 31, b = bh >> 2, h = bh & 3;
                bf16* OS = (bf16*)(ws + WS_OSCR);
#pragma unroll 1
                for (int u4 = 0; u4 < 4; ++u4) {
                    const int m = u4 >> 1; const int qb = (u4 & 1) ? sp : 63 - sp;
                    attn_body::attn_unit2<8>(b, qb, (const attn_body::bf16*)(P + PC_Q + h * 128 + m * 64), (const attn_body::bf16*)(P + PC_K + h * 128 + m * 64),
                                             (const attn_body::bf16*)(P + PC_VA + h * 128), (attn_body::bf16*)(OS + h * 256 + m * 128), xtab, (char*)lds_raw);
                    if (u4 >= 2) diff_combine(P, OS, b, h, qb, lam, args.in[I_SUBG] + l * 128, 1.0f - lam_init);
                }
                __syncthreads();
            }
#endif
            chunk_unit(lds, P, blk, (const bf16*)(ws + WS_WB) + (size_t)l * 4 * 128 * 128, args.in[I_GBS] + l * 512, (const bf16*)(ws + WS_PWT) + (size_t)l * 4 * 64 * 64, args.in[I_POOLS] + l * 256);
        }
        GRID_BAR();
        {   unsigned char* ws = opq(args.ws); const int blk = opaque_s((int)blockIdx.x), G = opaque_s((int)gridDim.x);
            Gemm g{(const bf16*)(ws + WS_P), (const bf16*)(ws + WS_WOUT) + (size_t)l * DM * DM, PP, DM};
            PairOrder S; S.c = blk;
            EpiResid E{(bf16*)(ws + WS_XB)};
            GEMM_PHASE(lds, g, S, E);
            pair_sync((unsigned*)((gu32*)(ws + WS_CTL) + CW_PAIR) + 16 * ((l * 2) * 128 + pair_panel(blk)), bar);
        }
        if (l == 0) ln_phase<0>(args, lds, opq(args.out), args.in[I_LN1G] + l * DM, args.in[I_LN1B] + l * DM, nullptr);
        else ln_phase<1>(args, lds, opq(args.out), args.in[I_LN1G] + l * DM, args.in[I_LN1B] + l * DM, args.in[I_RW]);
        if (l == 0) {
            {   unsigned char* ws = opq(args.ws); const int blk = opaque_s((int)blockIdx.x);
                unsigned* qw = (unsigned*)((gu32*)(ws + WS_CTL) + CW_PAIR) + 16 * (3 * 128 + quad_id(blk));
                pair_sync(qw, bar, 4u);
                Gemm g{(const bf16*)(ws + WS_XB), (const bf16*)(ws + WS_W13), DM, DM};
                QuadOrder S; S.c = blk; S.nn = 22;
                EpiSwiglu8 E{(unsigned char*)(ws + WS_HID), DFF};
                GEMM_PHASE(lds, g, S, E);
                pair_sync(qw + 16 * 64, bar, 4u);
            }
            {   unsigned char* ws = opq(args.ws); const int blk = opaque_s((int)blockIdx.x), G = opaque_s((int)gridDim.x);
                Gemm g{(const bf16*)(ws + WS_HID), (const bf16*)(ws + WS_W2), DFF, DFF, F8_E8_H, F8_E8_W};
                PairOrder S; S.c = blk;
                EpiResid E{(bf16*)(ws + WS_XB)};
                pg8::gemm_phase<EpiResid, PairOrder, false, false, true>(lds, g, S, E);
                pair_sync((unsigned*)((gu32*)(ws + WS_CTL) + CW_PAIR) + 16 * (1 * 128 + pair_panel(blk)), bar);
            }
            ln_phase<0>(args, lds, opq(args.out), args.in[I_LN2G] + l * DM, args.in[I_LN2B] + l * DM, nullptr);
        } else {
            GRID_BAR();
            unsigned char* ws = opq(args.ws); const int blk = opaque_s((int)blockIdx.x), G = opaque_s((int)gridDim.x);
            gu32* ctl = (gu32*)(ws + WS_CTL);
            bf16* asort = (bf16*)(ws + WS_ASORT); const bf16* xb = (const bf16*)(ws + WS_XB);
            int seg[9]; seg[0] = 0;
#pragma unroll
            for (int e = 0; e < 8; ++e) { const int cnt = __builtin_amdgcn_readfirstlane((int)__hip_atomic_load(ctl + CW_CUR + 64 * e, __ATOMIC_RELAXED, __HIP_MEMORY_SCOPE_AGENT)); seg[e + 1] = seg[e] + ((cnt + 255) & ~255); }
            const int ntot = seg[8] >> 8;
            MoeOrder S; S.ts1 = seg[1] >> 8; S.ts2 = seg[2] >> 8; S.ts3 = seg[3] >> 8; S.ts4 = seg[4] >> 8; S.ts5 = seg[5] >> 8; S.ts6 = seg[6] >> 8; S.ts7 = seg[7] >> 8; S.G = G; S.c = blk; S.rowtok = (const int*)(ws + WS_ROWTOK);
            const int nf = ntot >> 7, nr = ntot & 127, ns = nf + (nr > 0 ? 1 : 0);
            bf16* hbuf0 = (bf16*)opq(args.out); bf16* hbuf1 = (bf16*)(ws + WS_HCH);
            for (int j = 0; j <= ns; ++j) {
                if (j >= 1) {
                    const int jj = j - 1; const bool rem = (nr > 0 && jj == 0); const int k = jj - (nr > 0 ? 1 : 0);
                    S.c0 = rem ? nf * 128 : k * 128; S.ntc = rem ? nr : 128; S.ncol = 4; S.up = false; S.skipn = 0;
                    Gemm g{(jj & 1) ? hbuf1 : hbuf0, (const bf16*)(ws + WS_MW2), DFE, DFE, F8_E8_H, F8_E8_W};
                    EpiPlain E{asort, DM};
                    pg8::gemm_phase<EpiPlain, MoeOrder, false, false, true>(lds, g, S, E);
                }
                if (j < ns) {
                    const bool rem = (nr > 0 && j == 0); const int k = j - (nr > 0 ? 1 : 0);
                    const int ndown = (j >= 1) ? S.ntc * 4 : 0;
                    S.c0 = rem ? nf * 128 : k * 128; S.ntc = rem ? nr : 128; S.ncol = 28; S.up = true; S.skipn = (ndown > 0 && ndown < G) ? ndown : 0;
                    Gemm g{(const bf16*)(ws + WS_XB8), (const bf16*)(ws + WS_MW13), DM, DM, F8_E8_Y, F8_E8_W};
                    EpiSwiglu8 E{(unsigned char*)((j & 1) ? hbuf1 : hbuf0), DFE};
                    pg8::gemm_phase<EpiSwiglu8, MoeOrder, true, false, true>(lds, g, S, E);
                }
                GRID_BAR();
            }
            ln_phase<2>(args, lds, opq(args.out), args.in[I_LN2G] + l * DM, args.in[I_LN2B] + l * DM, nullptr);
        }
#undef GRID_BAR
}

__global__ void __launch_bounds__(NTHR, 2) fwd_kernel(Args args) {
    extern __shared__ __attribute__((aligned(16))) unsigned char lds_raw[];
    LAS unsigned char* lds = (LAS unsigned char*)lds_raw;
    {   const int tid = threadIdx.x;
        for (int u = tid; u < (LDS_BYTES - LDSCTL_OFF) / 4; u += NTHR) ((LAS unsigned*)(lds + LDSCTL_OFF))[u] = 0u;
        __syncthreads(); }
    XcdBarrier bar = xcd_barrier_post((unsigned*)((gu32*)(args.ws + WS_CTL) + CW_BAR), (volatile LAS unsigned*)(lds + MISC_OFF) + 8);
#define GRID_BAR() xcd_barrier(bar)

    {   const int tid = opaque_tid(), lane = tid & 63, wave = __builtin_amdgcn_readfirstlane(tid >> 6);
        prologue(args, lds, (int)blockIdx.x * NWAVES + wave, (int)gridDim.x * NWAVES, wave, lane); }
    {   const int blk = opaque_s((int)blockIdx.x); unsigned* xw = bar.bar + opaque0() - CW_BAR + CW_XCC + blk;
        if (opaque_tid() == 0) (void)xb_add(xw, bar.x + 1u); }
    GRID_BAR();

    layer_body<0>(args, lds, lds_raw, bar);
    layer_body<1>(args, lds, lds_raw, bar);
#undef GRID_BAR
}

extern "C" void kernel_launch(void* const* d_in, const int* in_sizes, int n_in, void* d_out, int out_size, void* d_ws, size_t ws_size, hipStream_t stream) {
    static int ready = 0;
    if (ready == 0) {
        if (n_in != 24 || in_sizes[0] != M * DM || out_size != M * DM || ws_size < WS_END) { fprintf(stderr, "kernel_launch: unexpected shapes (n_in %d, in0 %d, out %d, ws %zu)\n", n_in, n_in > 0 ? in_sizes[0] : -1, out_size, ws_size); ready = -1; return; }
        if (hipFuncSetAttribute((const void*)fwd_kernel, hipFuncAttributeMaxDynamicSharedMemorySize, LDS_BYTES) != hipSuccess) { fprintf(stderr, "kernel_launch: hipFuncSetAttribute failed\n"); ready = -1; return; }
        int per_cu = 0;
        if (hipOccupancyMaxActiveBlocksPerMultiprocessor(&per_cu, (const void*)fwd_kernel, NTHR, LDS_BYTES) != hipSuccess || per_cu < 1) fprintf(stderr, "kernel_launch: occupancy query says %d\n", per_cu);
        (void)hipGetLastError();
        ready = 1;
    }
    if (ready < 0) return;
    (void)hipMemsetAsync((char*)d_ws + WS_CTL, 0, CTL_ZERO_BYTES, stream);
    Args a{};
    for (int i = 0; i < 24; ++i) a.in[i] = (const float*)d_in[i];
    a.out = (float*)d_out; a.ws = (unsigned char*)d_ws;
    hipLaunchKernelGGL(fwd_kernel, dim3(GRID), dim3(NTHR), LDS_BYTES, stream, a);
}
```

```cpp
#include <hip/hip_runtime.h>
#include <cstdio>
#include <cstdint>

#define GAS __attribute__((address_space(1)))
#define LAS __attribute__((address_space(3)))
typedef unsigned short bf16;
typedef unsigned u32x4 __attribute__((ext_vector_type(4)));
typedef unsigned u32x2 __attribute__((ext_vector_type(2)));
typedef float f32x4 __attribute__((ext_vector_type(4)));
typedef float f32x2 __attribute__((ext_vector_type(2)));
typedef GAS unsigned gu32;

constexpr int BATCH = 2, SEQ = 16384, DM = 1024, M = BATCH * SEQ, DIN = 2304, DFF = 2816, NEXP = 8, DFE = 3584, DEPTH = 2;
constexpr float LN_EPS = 1e-5f;
constexpr float ALPHA = 1.4142135623730951f;
constexpr float LOG2E = 1.4426950408889634f;
constexpr float C2 = 0.125f * LOG2E;
constexpr int NWAVES = 8, NTHR = 512, GRID = 256;
constexpr int PP = DIN;
constexpr int PC_U = 0, PC_V = 256, PC_Q = 512, PC_K = 1024, PC_VA = 1536, PC_C = 2048;

constexpr size_t MiB = 1u << 20;
constexpr size_t WS_CTL = 0, CTL_ZERO_BYTES = 1 * MiB;
constexpr size_t WS_WB = 1 * MiB;
constexpr size_t WS_PWT = 1 * MiB + 256 * 1024;
constexpr size_t WS_ROUTE = 2 * MiB;
constexpr size_t WS_WIN = 4 * MiB;
constexpr size_t WS_WOUT = 13 * MiB;
constexpr size_t WS_W13 = 17 * MiB;
constexpr size_t WS_W2 = 28 * MiB;
constexpr size_t WS_MW13 = 34 * MiB;
constexpr size_t WS_MW2 = 146 * MiB;
constexpr size_t WS_XB = 202 * MiB;
constexpr size_t WS_BIG = 266 * MiB;
constexpr size_t WS_P = WS_BIG;
constexpr size_t WS_OSCR = WS_BIG + 144 * MiB;
constexpr size_t WS_HID = WS_BIG + 144 * MiB;
constexpr size_t WS_ASORT = WS_BIG;
constexpr size_t WS_HCH = WS_BIG + 132 * MiB;
constexpr size_t WS_XB8 = 96 * MiB;
constexpr size_t WS_ROWTOK = 510 * MiB;
constexpr size_t WS_END = 520 * MiB;
constexpr int CHUNK_TILES = 64;
constexpr int MAX_RT = 264;

constexpr int CW_BAR = 4096;
constexpr int CW_CUR = 16384;
constexpr int CW_XCC = 49152;
constexpr int CW_PAIR = 32768;

constexpr int RING_BYTES = 131072;
constexpr int LDSCTL_OFF = RING_BYTES, MISC_OFF = LDSCTL_OFF + 320;
constexpr int LDS_BYTES = 147456;

__device__ __forceinline__ unsigned f2bf(float f) { unsigned u = __builtin_bit_cast(unsigned, f); return (u + 0x7fffu + ((u >> 16) & 1u)) >> 16; }
__device__ __forceinline__ unsigned pk2(float lo, float hi) { return f2bf(lo) | (f2bf(hi) << 16); }
__device__ __forceinline__ float bflo(unsigned w) { return __builtin_bit_cast(float, w << 16); }
__device__ __forceinline__ float bfhi(unsigned w) { return __builtin_bit_cast(float, w & 0xffff0000u); }
__device__ __forceinline__ u32x2 pack4(f32x4 v) { u32x2 r; r.x = pk2(v.x, v.y); r.y = pk2(v.z, v.w); return r; }
__device__ __forceinline__ size_t opaque0() { unsigned z = 0u; asm volatile("" : "+s"(z)); return (size_t)z; }
__device__ __forceinline__ int opaque_tid() { int t = threadIdx.x; asm volatile("" : "+v"(t)); return t; }
__device__ __forceinline__ int opaque_s(int x) { asm volatile("" : "+s"(x)); return x; }
#define opq(p) ((p) + opaque0())
__device__ __forceinline__ float shx(float v, int lane, int o) { return __builtin_bit_cast(float, __builtin_amdgcn_ds_bpermute((lane ^ o) << 2, __builtin_bit_cast(int, v))); }
__device__ __forceinline__ float wave_sum(float v, int lane) {
#pragma unroll
    for (int o = 1; o < 64; o <<= 1) v += __builtin_bit_cast(float, __builtin_amdgcn_ds_bpermute((lane ^ o) << 2, __builtin_bit_cast(int, v)));
    return v;
}
__device__ __forceinline__ float gelu1(float v) {
    const float av = __builtin_fabsf(v), d = av * 0.2316418882f + 1.0f;
    const float t = __builtin_amdgcn_rcpf(d);
    float q = t * 0.5307027145f + (-0.7265760135f); q = q * t + 0.7107068705f; q = q * t + (-0.142248368f); q = q * t + 0.127414796f; q = q * t;
    const float s = (v * v) * (-0.72134752044f);
    const float e = __builtin_amdgcn_exp2f(s);
    const float m = v * (q * e), r = v - m;
    return v < 0.f ? m : r;
}
__device__ __forceinline__ f32x4 gelu4(f32x4 v) { f32x4 o; o.x = gelu1(v.x); o.y = gelu1(v.y); o.z = gelu1(v.z); o.w = gelu1(v.w); return o; }
__device__ __forceinline__ float silu1(float a) { return a * __builtin_amdgcn_rcpf(1.0f + __builtin_amdgcn_exp2f(-a * LOG2E)); }

#define XB_TMO      128
#define XB_XCNT(j)  (256  + 64 * (j))
#define XB_XSUB(j)  (1280 + 64 * (j))
#define XB_XGEN(j)  (2304 + 64 * (j))
#define XB_TOP      3328
#define XB_TOPGEN   3392
#define XCD_BAR_WORDS 3456
#define XB_SPIN_CAP (1u << 22)

__device__ __forceinline__ unsigned xb_ld(unsigned* p)              { return __hip_atomic_load(p, __ATOMIC_RELAXED, __HIP_MEMORY_SCOPE_AGENT); }
__device__ __forceinline__ unsigned xb_add(unsigned* p, unsigned v) { return __hip_atomic_fetch_add(p, v, __ATOMIC_RELAXED, __HIP_MEMORY_SCOPE_AGENT); }
__device__ __forceinline__ unsigned xb_xcc_id() { return (unsigned)__builtin_amdgcn_s_getreg((3 << 11) | 20) & 0xFu; }
#define XB_SPIN(cond, bar) do { unsigned _sp = 0; while (cond) { __builtin_amdgcn_s_sleep(1); \
    if ((++_sp & 255u) == 0u) { if (xb_ld(&(bar)[XB_TMO])) break; if (_sp > XB_SPIN_CAP) { atomicAdd(&(bar)[XB_TMO], 1u); break; } } } } while (0)

struct XcdBarrier { unsigned* bar; unsigned x; volatile LAS unsigned* st; };

__device__ __forceinline__ XcdBarrier xcd_barrier_post(unsigned* bar, volatile LAS unsigned* st) {
    XcdBarrier b; b.bar = bar; b.x = xb_xcc_id(); b.st = st;
    if (threadIdx.x == 0) (void)xb_add(&bar[XB_XCNT(b.x)], 1u);
    return b;
}
__device__ __forceinline__ void xcd_barrier_complete(unsigned* bar, unsigned x, unsigned& nloc, unsigned& nx) {
    const unsigned G = gridDim.x * gridDim.y * gridDim.z;
    unsigned sum, cnt, mine, sp = 0u;
    for (;;) {
        sum = 0u; cnt = 0u; mine = 0u;
#pragma unroll
        for (unsigned j = 0; j < 16; ++j) { const unsigned c = xb_ld(&bar[XB_XCNT(j)]); sum += c; cnt += (c > 0u) ? 1u : 0u; mine = (j == x) ? c : mine; }
        if (sum == G) break;
        __builtin_amdgcn_s_sleep(1);
        if ((++sp & 255u) == 0u) { if (xb_ld(&bar[XB_TMO])) break; if (sp > XB_SPIN_CAP) { atomicAdd(&bar[XB_TMO], 1u); break; } }
    }
    nloc = mine > 0u ? mine : 1u; nx = cnt > 0u ? cnt : 1u;
}
__device__ __forceinline__ void xcd_barrier(const XcdBarrier& b) {
    asm volatile("s_waitcnt vmcnt(0)" ::: "memory");
    __syncthreads();
    if (threadIdx.x == 0) {
        unsigned* bar = b.bar + opaque0();
        __builtin_amdgcn_s_waitcnt(0);
        unsigned nloc = b.st[0], nx = b.st[1];
        if (nloc == 0u) { xcd_barrier_complete(bar, b.x, nloc, nx); b.st[0] = nloc; b.st[1] = nx; }
        const unsigned old = xb_add(&bar[XB_XSUB(b.x)], 1u);
        const unsigned gen = old / nloc;
        if (old + 1u == (gen + 1u) * nloc) {
            __builtin_amdgcn_fence(__ATOMIC_RELEASE, "agent");
            asm volatile("s_waitcnt vmcnt(0)" ::: "memory");
            const unsigned og = xb_add(&bar[XB_TOP], 1u);
            const unsigned tg = og / nx;
            if (og + 1u == (tg + 1u) * nx) xb_add(&bar[XB_TOPGEN], 1u);
            else XB_SPIN(xb_ld(&bar[XB_TOPGEN]) == tg, bar);
            __builtin_amdgcn_fence(__ATOMIC_ACQUIRE, "agent");
            xb_add(&bar[XB_XGEN(b.x)], 1u);
            asm volatile("s_waitcnt vmcnt(0)" ::: "memory");
        } else {
            XB_SPIN(xb_ld(&bar[XB_XGEN(b.x)]) == gen, bar);
            __builtin_amdgcn_fence(__ATOMIC_ACQUIRE, "agent");
            asm volatile("s_waitcnt vmcnt(0)" ::: "memory");
        }
    }
    __syncthreads();
}

__device__ __forceinline__ void pair_sync(unsigned* w, const XcdBarrier& b, unsigned n = 2u) {
    asm volatile("s_waitcnt vmcnt(0)" ::: "memory");
    __syncthreads();
    if (threadIdx.x == 0) {
        unsigned* bar = b.bar + opaque0();
        bool same = true;
        for (unsigned j = 1; j < n; ++j) same = same && ((unsigned)__builtin_amdgcn_readfirstlane((int)xb_ld(bar - CW_BAR + CW_XCC + (blockIdx.x ^ (8u * j)))) == b.x + 1u);
        if (!same) { __builtin_amdgcn_fence(__ATOMIC_RELEASE, "agent"); asm volatile("s_waitcnt vmcnt(0)" ::: "memory"); }
        (void)xb_add(w, 1u);
        XB_SPIN(xb_ld(w) < n, bar);
        __builtin_amdgcn_fence(__ATOMIC_ACQUIRE, "agent");
        asm volatile("s_waitcnt vmcnt(0)" ::: "memory");
    }
    __syncthreads();
}
__device__ __forceinline__ int pair_panel(int c) { return (c & 7) * 16 + (c >> 4); }
__device__ __forceinline__ int pair_row0(int c) { return pair_panel(c) * 256 + ((c >> 3) & 1) * 128; }

struct Unit { int pm, pn, om, on, ge, gl; };
struct Gemm { const bf16* A; const bf16* Bt; int lda, K; int sa = 0, sb = 0; };

constexpr int NXCD = 8, WGM = 8;
struct StaticOrder {
    int nM, nN, nwg, G, c;
    __device__ __forceinline__ void init(int M_, int N_, int G_, int c_) { nM = M_ / 256; nN = N_ / 256; nwg = nM * nN; G = G_; c = c_; }
    __device__ __forceinline__ bool next(int i, Unit& u) const {
        long L = (long)i * G + c;
        {   const int full = nwg / G, part = nwg - full * G;
            if (i == full && part > 0) { if (c < G - part) return false; L = (long)i * G + (c - (G - part)); } }
        if (L >= nwg) return false;
        int wgid = (int)L; { const int q = nwg / NXCD, r = nwg % NXCD, xcd = wgid % NXCD, off = wgid / NXCD; wgid = (xcd < r ? xcd * (q + 1) : r * (q + 1) + (xcd - r) * q) + off; }
        const int nig = WGM * nN, gid = wgid / nig, fm = gid * WGM, gsz = (nM - fm) < WGM ? (nM - fm) : WGM;
        u.pm = fm + ((wgid % nig) % gsz); u.pn = (wgid % nig) / gsz; u.om = u.pm; u.on = u.pn; return true;
    }
    __device__ __forceinline__ void a_ready(const Unit&) const {}
    __device__ __forceinline__ void done(const Unit&) const {}
};
struct PairOrder {
    int c;
    __device__ __forceinline__ bool next(int i, Unit& u) const { if (i >= 2) return false; u.pm = pair_panel(c); u.pn = ((c >> 3) & 1) * 2 + i; u.om = u.pm; u.on = u.pn; return true; }
    __device__ __forceinline__ void a_ready(const Unit&) const {}
    __device__ __forceinline__ void done(const Unit&) const {}
};
struct QuadOrder {
    int c, nn;
    __device__ __forceinline__ bool next(int i, Unit& u) const { const int uu = i * 4 + ((c >> 3) & 3), hi = uu >= nn ? 1 : 0; if (uu >= 2 * nn) return false;
        int pn = uu - nn * hi;
        if (nn == 9 && pn < 4) pn = hi ? ((0x3102 >> (4 * pn)) & 3) : (pn ^ 2);
        u.pm = (c & 7) * 16 + (c >> 5) * 2 + hi; u.pn = pn; u.om = u.pm; u.on = u.pn; return true; }
    __device__ __forceinline__ void a_ready(const Unit&) const {}
    __device__ __forceinline__ void done(const Unit&) const {}
};
__device__ __forceinline__ int quad_id(int c) { return (c & 7) * 8 + (c >> 5); }
struct MoeOrder {
    int ts1, ts2, ts3, ts4, ts5, ts6, ts7;
    const int* rowtok;
    int c0, ntc, ncol, G, c, skipn; bool up;
    __device__ __forceinline__ bool next(int i, Unit& u) const {
        if (up && ntc == 128 && G == 256) {
            const int D = skipn, x = (D > 0) ? (3584 - (7 * (256 - D)) / 2 + 128) / 256 : 14, nx = 14 - x;
            int oc = c, oi = i;
            if (c < D) { if (i >= x) return false; }
            else if (i >= 14) { const int o = (c - D) + (i - 14) * (256 - D); if (nx == 0 || o >= D * nx) return false; oc = o / nx; oi = x + o % nx; }
            const int li = oc >> 3, rtl = (oc & 7) * 16 + (li >> 1), pn = (li & 1) * 14 + oi, rt = c0 + rtl;
            const int e = (rt >= ts1) + (rt >= ts2) + (rt >= ts3) + (rt >= ts4) + (rt >= ts5) + (rt >= ts6) + (rt >= ts7);
            int tse = 0; tse = (e == 1) ? ts1 : tse; tse = (e == 2) ? ts2 : tse; tse = (e == 3) ? ts3 : tse; tse = (e == 4) ? ts4 : tse; tse = (e == 5) ? ts5 : tse; tse = (e == 6) ? ts6 : tse; tse = (e == 7) ? ts7 : tse;
            u.pn = e * ncol + pn; u.on = pn; u.pm = rt; u.om = rtl; u.ge = e; u.gl = rt - tse; return true; }
        if (!up && ntc == 128 && G == 256) {
            if (i >= 2) return false;
            const int li = c >> 3, rtl = (c & 7) * 16 + (li >> 1), pn = (li & 1) * 2 + i, rt = c0 + rtl;
            const int e = (rt >= ts1) + (rt >= ts2) + (rt >= ts3) + (rt >= ts4) + (rt >= ts5) + (rt >= ts6) + (rt >= ts7);
            u.pn = e * ncol + pn; u.on = pn; u.pm = rtl; u.om = rt; return true; }
        long L = (long)i * G + c;
        if (skipn > 0) { const int act = G - skipn; L = (c < skipn) ? 3L * act + (long)i * G + c : ((i < 3) ? (long)i * act + (c - skipn) : 3L * act + (long)(i - 3) * G + c); }
        if (L >= (long)ntc * ncol) return false;
        const int rtl = (int)(L / ncol), pn = (int)(L % ncol), rt = c0 + rtl;
        const int e = (rt >= ts1) + (rt >= ts2) + (rt >= ts3) + (rt >= ts4) + (rt >= ts5) + (rt >= ts6) + (rt >= ts7);
        u.pn = e * ncol + pn; u.on = pn;
        if (up) { u.pm = rt; u.om = rtl; u.ge = e;
            int tse = 0; tse = (e == 1) ? ts1 : tse; tse = (e == 2) ? ts2 : tse; tse = (e == 3) ? ts3 : tse; tse = (e == 4) ? ts4 : tse; tse = (e == 5) ? ts5 : tse; tse = (e == 6) ? ts6 : tse; tse = (e == 7) ? ts7 : tse;
            u.gl = rt - tse; }
        else { u.pm = rtl; u.om = rt; }
        return true;
    }
    __device__ __forceinline__ void a_ready(const Unit&) const {}
    __device__ __forceinline__ void done(const Unit&) const {}
};

__device__ __forceinline__ u32x4 pack8(f32x4 a, f32x4 b) { u32x4 r; r.x = pk2(a.x, a.y); r.y = pk2(a.z, a.w); r.z = pk2(b.x, b.y); r.w = pk2(b.z, b.w); return r; }
struct EpiInProj { bf16* P; static constexpr bool PERM = true;
    __device__ __forceinline__ void emit8(int row, int on, int c, f32x4 lo0, f32x4 lo1, f32x4 hi0, f32x4 hi1) const {
        if (on < 2) { lo0 = gelu4(lo0); lo1 = gelu4(lo1); hi0 = gelu4(hi0); hi1 = gelu4(hi1); } else if (on < 4) { lo0 = lo0 * C2; lo1 = lo1 * C2; hi0 = hi0 * C2; hi1 = hi1 * C2; }
        bf16* rp = P + (size_t)row * PP + on * 256 + c;
        *(u32x4*)rp = pack8(lo0, lo1); *(u32x4*)(rp + 128) = pack8(hi0, hi1);
    }
    __device__ __forceinline__ void emit(int row, int on, int c, f32x4 lo, f32x4 hi) const {
        if (on < 2) { lo = gelu4(lo); hi = gelu4(hi); } else if (on < 4) { lo = lo * C2; hi = hi * C2; }
        bf16* rp = P + (size_t)row * PP + on * 256 + c;
        *(u32x2*)rp = pack4(lo); *(u32x2*)(rp + 128) = pack4(hi);
    } };
struct EpiResid { bf16* xb; static constexpr bool PERM = true;
    __device__ __forceinline__ void emit8(int row, int on, int c, f32x4 lo0, f32x4 lo1, f32x4 hi0, f32x4 hi1) const {
        bf16* rp = xb + (size_t)row * DM + on * 256 + c;
        const u32x4 a = *(const u32x4*)rp, b = *(const u32x4*)(rp + 128);
        const f32x4 a0 = {bflo(a.x), bfhi(a.x), bflo(a.y), bfhi(a.y)}, a1 = {bflo(a.z), bfhi(a.z), bflo(a.w), bfhi(a.w)};
        const f32x4 b0 = {bflo(b.x), bfhi(b.x), bflo(b.y), bfhi(b.y)}, b1 = {bflo(b.z), bfhi(b.z), bflo(b.w), bfhi(b.w)};
        *(u32x4*)rp = pack8(a0 * ALPHA + lo0, a1 * ALPHA + lo1); *(u32x4*)(rp + 128) = pack8(b0 * ALPHA + hi0, b1 * ALPHA + hi1);
    }
    __device__ __forceinline__ void emit(int, int, int, f32x4, f32x4) const {} };
struct EpiSwiglu { bf16* H; int ldh; static constexpr bool PERM = true;
    __device__ __forceinline__ void emit8(int row, int on, int c, f32x4 lo0, f32x4 lo1, f32x4 hi0, f32x4 hi1) const {
        f32x4 v0, v1; v0.x = silu1(lo0.x) * hi0.x; v0.y = silu1(lo0.y) * hi0.y; v0.z = silu1(lo0.z) * hi0.z; v0.w = silu1(lo0.w) * hi0.w;
        v1.x = silu1(lo1.x) * hi1.x; v1.y = silu1(lo1.y) * hi1.y; v1.z = silu1(lo1.z) * hi1.z; v1.w = silu1(lo1.w) * hi1.w;
        const int col = on * 128 + c;
        *(u32x4*)(H + (size_t)(row >> 1) * (2 * ldh) + (col >> 5) * 64 + (row & 1) * 32 + (col & 31)) = pack8(v0, v1);
    }
    __device__ __forceinline__ void emit(int, int, int, f32x4, f32x4) const {} };
constexpr float F8_SC_Y = 16.0f, F8_SC_H = 16.0f, F8_SC_W = 64.0f;
constexpr int F8_E8_Y = 0x7a7a7a7a, F8_E8_H = 0x7a7a7a7a, F8_E8_W = 0x7a7a7a7a;
__device__ __forceinline__ float f8clamp(float v) { return __builtin_amdgcn_fmed3f(v, -448.0f, 448.0f); }
__device__ __forceinline__ unsigned pk4f8(float a, float b, float c, float d) { int p = 0; p = __builtin_amdgcn_cvt_pk_fp8_f32(f8clamp(a), f8clamp(b), p, false); p = __builtin_amdgcn_cvt_pk_fp8_f32(f8clamp(c), f8clamp(d), p, true); return (unsigned)p; }
struct EpiSwiglu8 { unsigned char* H; int ldh; static constexpr bool PERM = true;
    __device__ __forceinline__ void emit8(int row, int on, int c, f32x4 lo0, f32x4 lo1, f32x4 hi0, f32x4 hi1) const {
        f32x4 v0, v1; v0.x = silu1(lo0.x) * hi0.x; v0.y = silu1(lo0.y) * hi0.y; v0.z = silu1(lo0.z) * hi0.z; v0.w = silu1(lo0.w) * hi0.w;
        v1.x = silu1(lo1.x) * hi1.x; v1.y = silu1(lo1.y) * hi1.y; v1.z = silu1(lo1.z) * hi1.z; v1.w = silu1(lo1.w) * hi1.w;
        v0 = v0 * F8_SC_H; v1 = v1 * F8_SC_H;
        *(u32x2*)(H + (size_t)row * ldh + on * 128 + c) = (u32x2){pk4f8(v0.x, v0.y, v0.z, v0.w), pk4f8(v1.x, v1.y, v1.z, v1.w)};
    }
    __device__ __forceinline__ void emit(int, int, int, f32x4, f32x4) const {} };
struct EpiPlain { bf16* O; int ldo; static constexpr bool PERM = true;
    __device__ __forceinline__ void emit8(int row, int on, int c, f32x4 lo0, f32x4 lo1, f32x4 hi0, f32x4 hi1) const {
        bf16* rp = O + (size_t)row * ldo + on * 256 + c;
        *(u32x4*)rp = pack8(lo0, lo1); *(u32x4*)(rp + 128) = pack8(hi0, hi1);
    }
    __device__ __forceinline__ void emit(int row, int on, int c, f32x4 lo, f32x4 hi) const {
        bf16* rp = O + (size_t)row * ldo + on * 256 + c;
        *(u32x2*)rp = pack4(lo); *(u32x2*)(rp + 128) = pack4(hi);
    } };

template <class Epi, class Sched>
__device__ __forceinline__ void ngemm_phase(LAS unsigned char* lds, const Gemm g, const Sched& S, const Epi& E) {
    const int tid = opaque_tid(), ty = tid >> 5, tx = tid & 31;
    LAS float* As = (LAS float*)lds;
    LAS float* Bs = As + 16 * 132;
    Unit u;
    for (int it = 0; S.next(it, u); ++it) {
        for (int half = 0; half < 2; ++half) {
            float acc[8][8];
#pragma unroll
            for (int i = 0; i < 8; ++i)
#pragma unroll
                for (int j = 0; j < 8; ++j) acc[i][j] = 0.f;
            const bf16* Ap = g.A + (size_t)(u.pm * 256 + half * 128 + (tid >> 2)) * g.lda + (tid & 3) * 4;
            const bf16* Bp = g.Bt + (size_t)(u.pn * 256 + (tid >> 1)) * g.K + (tid & 1) * 8;
            for (int k0 = 0; k0 < g.K; k0 += 16) {
                const u32x2 av = *(const u32x2*)(Ap + k0);
                const u32x4 bv = *(const u32x4*)(Bp + k0);
                __syncthreads();
                { LAS float* a = As + ((tid & 3) * 4) * 132 + (tid >> 2);
                  a[0] = bflo(av.x); a[132] = bfhi(av.x); a[264] = bflo(av.y); a[396] = bfhi(av.y);
                  LAS float* b = Bs + ((tid & 1) * 8) * 260 + (tid >> 1);
                  b[0] = bflo(bv.x); b[260] = bfhi(bv.x); b[520] = bflo(bv.y); b[780] = bfhi(bv.y);
                  b[1040] = bflo(bv.z); b[1300] = bfhi(bv.z); b[1560] = bflo(bv.w); b[1820] = bfhi(bv.w); }
                __syncthreads();
#pragma unroll 2
                for (int kk = 0; kk < 16; ++kk) {
                    const f32x4 a0 = *(const LAS f32x4*)(As + kk * 132 + ty * 8), a1 = *(const LAS f32x4*)(As + kk * 132 + ty * 8 + 4);
                    const f32x4 b0 = *(const LAS f32x4*)(Bs + kk * 260 + tx * 4), b1 = *(const LAS f32x4*)(Bs + kk * 260 + 128 + tx * 4);
                    const float a[8] = {a0.x, a0.y, a0.z, a0.w, a1.x, a1.y, a1.z, a1.w};
                    const float b[8] = {b0.x, b0.y, b0.z, b0.w, b1.x, b1.y, b1.z, b1.w};
#pragma unroll
                    for (int i = 0; i < 8; ++i)
#pragma unroll
                        for (int j = 0; j < 8; ++j) acc[i][j] += a[i] * b[j];
                }
            }
#pragma unroll
            for (int i = 0; i < 8; ++i) {
                const f32x4 lo = {acc[i][0], acc[i][1], acc[i][2], acc[i][3]}, hi = {acc[i][4], acc[i][5], acc[i][6], acc[i][7]};
                E.emit(u.om * 256 + half * 128 + ty * 8 + i, u.on, tx * 4, lo, hi);
            }
        }
    }
    __syncthreads();
}


namespace pg8 {
__device__ __forceinline__ void glds_so(unsigned long long sbase, unsigned voff, unsigned lds_dst) { unsigned keep;
    asm volatile("s_mov_b32 %0, m0\n\ts_mov_b32 m0, %3\n\ts_nop 0\n\tglobal_load_lds_dwordx4 %1, %2\n\ts_mov_b32 m0, %0" : "=&s"(keep) : "v"(voff), "s"(sbase), "s"(lds_dst) : "memory"); }
typedef short bf16x8 __attribute__((ext_vector_type(8)));
typedef int i32x4_t __attribute__((ext_vector_type(4)));
typedef int i32x8_t __attribute__((ext_vector_type(8)));
typedef short s16x16_t __attribute__((ext_vector_type(16)));
constexpr int BM = 256, BK = 64, HALF = 128, HTB = HALF * BK * 2, STAGE_BYTES = 8 * HTB;
__device__ __forceinline__ int lds_byte(int r, int c) { const int st = (r >> 4) * 2 + (c >> 5), rr = r & 15, cc = c & 31, ob = rr * 64 + cc * 2; return st * 1024 + (ob ^ (((ob >> 9) & 1) << 5)); }
__device__ __forceinline__ int perm32(int rho) { const int n = rho >> 4, i = rho & 15; return 8 * (i >> 2) + 4 * n + (i & 3); }
__device__ __forceinline__ void stage_rc(int b, int& R, int& C) { const int st = b / 1024, sb = b % 1024, swz = sb ^ (((sb >> 9) & 1) << 5); R = (st >> 1) * 16 + swz / 64; C = (st & 1) * 32 + (swz % 64) / 2; }
template <class Epi, class Sched, bool GATHER = false, bool PAIRA = false, bool F8 = false>
__device__ __forceinline__ void gemm_phase(LAS unsigned char* lds, const Gemm g, const Sched& S, const Epi& E) {
    const int tid = opaque_tid(), wid = __builtin_amdgcn_readfirstlane(tid >> 6), lane = tid & 63, wr = wid >> 2, wc = wid & 3, fr = lane & 15, fq = lane >> 4;
    const int K = g.K, nt = F8 ? K / 128 : K / BK, lda = g.lda; const int sc2 = g.sa;
    unsigned voffA[2], voffB[2];
#pragma unroll
    for (int i = 0; i < 2; ++i) { int R, C; stage_rc(tid * 16 + i * 8192, R, C); const int Rb = Epi::PERM ? ((R & ~31) + perm32(R & 31)) : R;
        voffA[i] = F8 ? (unsigned)(R * lda + 2 * C) : PAIRA ? (unsigned)((R >> 1) * (2 * lda) + (C >> 5) * 64 + (R & 1) * 32 + (C & 31)) * 2u : (unsigned)(R * lda + C) * 2u; voffB[i] = F8 ? (unsigned)(Rb * K + 2 * C) : (unsigned)(Rb * K + C) * 2u; }
    const size_t kstep = (size_t)(BK * 2), kstepA = PAIRA ? 2 * kstep : kstep;
    const size_t hstepA = (size_t)HALF * lda * (F8 ? 1 : 2), hstepB = (size_t)HALF * K * (F8 ? 1 : 2);
    const size_t tstepA = 2 * hstepA, tstepB = 2 * hstepB;
    const unsigned ldsw = (unsigned)wid * 1024u;
    const unsigned ldsb = (unsigned)__builtin_amdgcn_readfirstlane((int)((unsigned)(uintptr_t)lds + ldsw));
    const int loff = F8 ? lds_byte(fr, fq * 16) : lds_byte(fr, fq * 8); const int aoff = wr * 8192 + loff, boff = wc * 4096 + loff;
#define PG8_SA(b, h) (((b) * 2 + (h)) * HTB)
#define PG8_SB(b, h) ((4 + (b) * 2 + (h)) * HTB)
#define PG8_STAGE(bufoff, gbase, voff) do { \
        if constexpr (F8) { const unsigned long long b_ = (unsigned long long)(gbase); \
            const unsigned long long sb_ = ((unsigned long long)(unsigned)__builtin_amdgcn_readfirstlane((int)(b_ >> 32)) << 32) | (unsigned)__builtin_amdgcn_readfirstlane((int)b_); \
            const bool isB_ = ((const void*)(voff) == (const void*)voffB), isA_ = ((const void*)(voff) == (const void*)voffA);     \
            if (isB_ || isA_) { const unsigned long long d_ = 64ull * (unsigned)(isB_ ? K : lda);     \
                glds_so(sb_, (voff)[0], ldsb + (unsigned)(bufoff)); glds_so(sb_ + d_, (voff)[0], ldsb + (unsigned)((bufoff) + 8192)); } \
            else { _Pragma("unroll") for (int _i = 0; _i < 2; ++_i) glds_so(sb_, (voff)[_i], ldsb + (unsigned)((bufoff) + _i * 8192)); } }     \
        else { _Pragma("unroll") for (int _i = 0; _i < 2; ++_i) __builtin_amdgcn_global_load_lds((const unsigned*)((const char*)(gbase) + (voff)[_i]), (LAS unsigned*)(lds + (bufoff) + ldsw + _i * 8192), 16, 0, 0); } } while (0)
#define PG8_LDA(dst, b, h) do { if constexpr (F8) { _Pragma("unroll") for (int m = 0; m < 4; ++m) dst##8[m] = __builtin_bit_cast(i32x8_t, *(const LAS s16x16_t*)(lds + PG8_SA(b, h) + aoff + m * 2048)); } \
        else { _Pragma("unroll") for (int m = 0; m < 4; ++m) _Pragma("unroll") for (int k = 0; k < 2; ++k) dst[m][k] = *(const LAS bf16x8*)(lds + PG8_SA(b, h) + aoff + m * 2048 + k * 1024); } } while (0)
#define PG8_LDB(dst, b, h) do { if constexpr (F8) { _Pragma("unroll") for (int n = 0; n < 2; ++n) dst##8[n] = __builtin_bit_cast(i32x8_t, *(const LAS s16x16_t*)(lds + PG8_SB(b, h) + boff + n * 2048)); } \
        else { _Pragma("unroll") for (int n = 0; n < 2; ++n) _Pragma("unroll") for (int k = 0; k < 2; ++k) dst[n][k] = *(const LAS bf16x8*)(lds + PG8_SB(b, h) + boff + n * 2048 + k * 1024); } } while (0)
#define PG8_CAT(a_, b_) __builtin_shufflevector(__builtin_bit_cast(i32x4_t, a_), __builtin_bit_cast(i32x4_t, b_), 0, 1, 2, 3, 4, 5, 6, 7)
#define PG8_MMA(ai, bj, At, Bt) do { __builtin_amdgcn_s_setprio(1); \
        if constexpr (F8) { _Pragma("unroll") for (int m = 0; m < 4; ++m) _Pragma("unroll") for (int n = 0; n < 2; ++n) \
            acc[ai][bj][m][n] = __builtin_amdgcn_mfma_scale_f32_16x16x128_f8f6f4(Bt##8[n], At##8[m], acc[ai][bj][m][n], 0, 0, 0, sc2, 0, sc2); } \
        else { _Pragma("unroll") for (int m = 0; m < 4; ++m) _Pragma("unroll") for (int n = 0; n < 2; ++n) _Pragma("unroll") for (int k = 0; k < 2; ++k) \
            acc[ai][bj][m][n] = __builtin_amdgcn_mfma_f32_16x16x32_bf16(Bt[n][k], At[m][k], acc[ai][bj][m][n], 0, 0, 0); } \
        __builtin_amdgcn_s_setprio(0); } while (0)
#define PG8_WAIT_V(n) asm volatile("s_waitcnt vmcnt(" #n ")" ::: "memory")
#define PG8_WAIT_L(n) asm volatile("s_waitcnt lgkmcnt(" #n ")" ::: "memory")
#define PG8_BAR __builtin_amdgcn_s_barrier()
#define PG8_SCHED __builtin_amdgcn_sched_barrier(0)
    Unit cur, nxt; int ui = 0;
    if (!S.next(0, cur)) return;
    unsigned gA0[2] = {0u, 0u}, gA1[2] = {0u, 0u};
    const char* gbaseA = (const char*)g.A;
#define PG8_GLOAD(u, r) do { _Pragma("unroll") for (int i_ = 0; i_ < 2; ++i_) { int R_, C_; stage_rc(tid * 16 + i_ * 8192, R_, C_); const int* tp_ = S.rowtok + ((u).ge * 32768 + (u).gl * 256 + R_); r[2 * i_] = tp_[0]; r[2 * i_ + 1] = tp_[128]; } } while (0)
#define PG8_GOFF(r, o0, o1) do { _Pragma("unroll") for (int i_ = 0; i_ < 2; ++i_) { int R_, C_; stage_rc(tid * 16 + i_ * 8192, R_, C_); o0[i_] = F8 ? (unsigned)(r[2 * i_] * lda + 2 * C_) : (unsigned)(r[2 * i_] * lda + C_) * 2u; o1[i_] = F8 ? (unsigned)(r[2 * i_ + 1] * lda + 2 * C_) : (unsigned)(r[2 * i_ + 1] * lda + C_) * 2u; } } while (0)
#define PG8_STAGE_A(bufoff, ptr, kofs, offs) do { if constexpr (GATHER) PG8_STAGE(bufoff, gbaseA + (kofs), offs); else PG8_STAGE(bufoff, ptr, voffA); } while (0)
    int raw[4] = {0, 0, 0, 0};
    if constexpr (GATHER) { PG8_GLOAD(cur, raw); PG8_GOFF(raw, gA0, gA1); }
    f32x4 acc[2][2][4][2];
#pragma unroll
    for (int a = 0; a < 2; ++a)
#pragma unroll
        for (int b = 0; b < 2; ++b)
#pragma unroll
            for (int m = 0; m < 4; ++m)
#pragma unroll
                for (int n = 0; n < 2; ++n) acc[a][b][m][n] = (f32x4){0.f, 0.f, 0.f, 0.f};
    bf16x8 At[4][2], B0[2][2], B1[2][2]; i32x8_t At8[4], B08[2], B18[2];
#define PG8_SPTR(p_) (F8 ? (const char*)(((unsigned long long)(unsigned)__builtin_amdgcn_readfirstlane((int)((unsigned long long)(p_) >> 32)) << 32) | (unsigned)__builtin_amdgcn_readfirstlane((int)(unsigned long long)(p_))) : (const char*)(p_))
    const char* cA = PG8_SPTR((const char*)g.A + (size_t)cur.pm * tstepA); const char* cB = PG8_SPTR((const char*)g.Bt + (size_t)cur.pn * tstepB);
    S.a_ready(cur);
    PG8_STAGE(PG8_SB(0, 0), cB, voffB); PG8_STAGE(PG8_SB(0, 1), cB + hstepB, voffB); PG8_STAGE_A(PG8_SA(0, 0), cA, 0, gA0); PG8_STAGE_A(PG8_SA(0, 1), cA + hstepA, 0, gA1);
    if (wr == 1) PG8_BAR;
    PG8_WAIT_V(2); PG8_BAR;
    PG8_STAGE(PG8_SB(1, 0), cB + kstep, voffB); PG8_STAGE_A(PG8_SA(1, 0), cA + kstepA, kstep, gA0); PG8_STAGE(PG8_SB(1, 1), cB + hstepB + kstep, voffB);
    PG8_WAIT_V(6); PG8_BAR;
    for (;;) {
        const bool has_next = S.next(ui + 1, nxt);
        const char* nA = PG8_SPTR(has_next ? (const char*)g.A + (size_t)nxt.pm * tstepA : cA); const char* nB = PG8_SPTR(has_next ? (const char*)g.Bt + (size_t)nxt.pn * tstepB : cB);
        const bool gsw = GATHER && has_next && (nxt.ge != cur.ge || nxt.gl != cur.gl);
#pragma unroll 1
        for (int t = 0; t < nt; t += 2) {
            const bool last = (t == nt - 2);
            const size_t k1 = (size_t)(t + 1) * kstep, k2 = last ? (size_t)0 : (size_t)(t + 2) * kstep, k3 = k2 + kstep;
            const char* a1 = cA + (size_t)(t + 1) * kstepA;
            const char* a2 = last ? nA : cA + (size_t)(t + 2) * kstepA; const char* b2 = last ? nB : cB + (size_t)(t + 2) * kstep;
            const char* a3 = a2 + kstepA; const char* b3 = b2 + kstep;
            if (last && has_next) S.a_ready(nxt);
            PG8_LDB(B0, 0, 0); PG8_LDB(B1, 0, 1); PG8_SCHED; PG8_LDA(At, 0, 0); PG8_STAGE_A(PG8_SA(1, 1), a1 + hstepA, k1, gA1);
            if constexpr (GATHER) { if (last && gsw) { PG8_GLOAD(nxt, raw); PG8_GOFF(raw, gA0, gA1); } }
            PG8_WAIT_V(8); PG8_WAIT_L(0); PG8_BAR; PG8_MMA(0, 0, At, B0); PG8_MMA(0, 1, At, B1); PG8_BAR; PG8_SCHED;
            PG8_LDA(At, 0, 1); PG8_STAGE(PG8_SB(0, 0), b2, voffB); PG8_STAGE(PG8_SB(0, 1), b2 + hstepB, voffB); PG8_STAGE_A(PG8_SA(0, 0), a2, k2, gA0);
            PG8_WAIT_V(8); PG8_WAIT_L(0); PG8_BAR; PG8_MMA(1, 0, At, B0); PG8_MMA(1, 1, At, B1); PG8_BAR; PG8_SCHED;
            PG8_LDB(B0, 1, 0); PG8_LDB(B1, 1, 1); PG8_SCHED; PG8_LDA(At, 1, 0); PG8_STAGE_A(PG8_SA(0, 1), a2 + hstepA, k2, gA1);
            PG8_WAIT_V(8); PG8_WAIT_L(0); PG8_BAR; PG8_MMA(0, 0, At, B0); PG8_MMA(0, 1, At, B1); PG8_BAR; PG8_SCHED;
            PG8_LDA(At, 1, 1); PG8_STAGE(PG8_SB(1, 0), b3, voffB); PG8_STAGE(PG8_SB(1, 1), b3 + hstepB, voffB); PG8_STAGE_A(PG8_SA(1, 0), a3, k3, gA0);
            PG8_WAIT_V(8); PG8_WAIT_L(0); PG8_BAR; PG8_MMA(1, 0, At, B0); PG8_MMA(1, 1, At, B1); PG8_BAR; PG8_SCHED;
        }
        if (wr == 0) PG8_BAR;
        {
            int fr_e = fr, fq_e = fq;
            if constexpr (F8) { const int l2_ = opaque_tid() & 63; fr_e = l2_ & 15; fq_e = l2_ >> 4; }
#pragma unroll
            for (int ai = 0; ai < 2; ++ai)
#pragma unroll
                for (int m = 0; m < 4; ++m) { const int row = cur.om * BM + ai * HALF + wr * 64 + m * 16 + fr_e;
                    if constexpr (Epi::PERM) E.emit8(row, cur.on, wc * 32 + 8 * fq_e, acc[ai][0][m][0], acc[ai][0][m][1], acc[ai][1][m][0], acc[ai][1][m][1]);
                    else {
#pragma unroll
                    for (int n = 0; n < 2; ++n) E.emit(row, cur.on, wc * 32 + n * 16 + fq * 4, acc[ai][0][m][n], acc[ai][1][m][n]); } }
            S.done(cur);
        }
        if (!has_next) break;
#pragma unroll
        for (int a = 0; a < 2; ++a)
#pragma unroll
            for (int b = 0; b < 2; ++b)
#pragma unroll
                for (int m = 0; m < 4; ++m)
#pragma unroll
                    for (int n = 0; n < 2; ++n) acc[a][b][m][n] = (f32x4){0.f, 0.f, 0.f, 0.f};
        cur = nxt; cA = nA; cB = nB; ++ui;
        if (wr == 1) PG8_BAR;
    }
    PG8_WAIT_V(0);
    PG8_BAR;
#undef PG8_SA
#undef PG8_SB
#undef PG8_STAGE
#undef PG8_STAGE_A
#undef PG8_SPTR
#undef PG8_GLOAD
#undef PG8_GOFF
#undef PG8_LDA
#undef PG8_LDB
#undef PG8_MMA
#undef PG8_CAT
#undef PG8_WAIT_V
#undef PG8_WAIT_L
#undef PG8_BAR
#undef PG8_SCHED
}
}
#ifndef USE_NAIVE_GEMM
#define GEMM_PHASE pg8::gemm_phase
#else
#define GEMM_PHASE ngemm_phase
#endif

struct Args { const float* in[24]; float* out; unsigned char* ws; };
enum { I_X = 0, I_WIN, I_WOUT, I_GWS, I_GBS, I_LQ1, I_LK1, I_LQ2, I_LK2, I_SUBG, I_RELB, I_POOLW, I_POOLS, I_LN1G, I_LN1B, I_LN2G, I_LN2B,
       I_FW1, I_FW3, I_FW2, I_RW, I_MW1, I_MW3, I_MW2 };

__device__ __forceinline__ void tr_item8(const float* src, int ld, int k0s, int n0s, unsigned char* dst, int ldd, int n0d, int k0d, LAS float* scr, int lane) {
#pragma unroll 8
    for (int i = 0; i < 32; ++i) { const int kk = 2 * i + (lane >> 5); scr[kk * 33 + (lane & 31)] = __builtin_nontemporal_load(src + (size_t)(k0s + kk) * ld + n0s + (lane & 31)) * F8_SC_W; }
    asm volatile("s_waitcnt lgkmcnt(0)" ::: "memory");
    const int c = lane & 3;
#pragma unroll
    for (int j = 0; j < 2; ++j) { const int n = (lane >> 2) + 16 * j; const LAS float* q = scr + (16 * c) * 33 + n;
        u32x4 o; o.x = pk4f8(q[0 * 33], q[1 * 33], q[2 * 33], q[3 * 33]); o.y = pk4f8(q[4 * 33], q[5 * 33], q[6 * 33], q[7 * 33]);
        o.z = pk4f8(q[8 * 33], q[9 * 33], q[10 * 33], q[11 * 33]); o.w = pk4f8(q[12 * 33], q[13 * 33], q[14 * 33], q[15 * 33]);
        *(u32x4*)(dst + (size_t)(n0d + n) * ldd + k0d + 16 * c) = o; }
    asm volatile("s_waitcnt lgkmcnt(0)" ::: "memory");
}
__device__ __forceinline__ void tr_item(const float* src, int ld, int k0s, int n0s, bf16* dst, int ldd, int n0d, int k0d, LAS float* scr, int lane) {
#pragma unroll 8
    for (int i = 0; i < 32; ++i) { const int kk = 2 * i + (lane >> 5); scr[kk * 33 + (lane & 31)] = __builtin_nontemporal_load(src + (size_t)(k0s + kk) * ld + n0s + (lane & 31)); }
    asm volatile("s_waitcnt lgkmcnt(0)" ::: "memory");
    const int c = lane & 7;
#pragma unroll
    for (int j = 0; j < 4; ++j) { const int n = (lane >> 3) + 8 * j; const LAS float* s = scr + (8 * c) * 33 + n;
        u32x4 o; o.x = pk2(s[0 * 33], s[1 * 33]); o.y = pk2(s[2 * 33], s[3 * 33]); o.z = pk2(s[4 * 33], s[5 * 33]); o.w = pk2(s[6 * 33], s[7 * 33]);
        *(u32x4*)(dst + (size_t)(n0d + n) * ldd + k0d + 8 * c) = o; }
    asm volatile("s_waitcnt lgkmcnt(0)" ::: "memory");
}

__device__ __forceinline__ void prologue(const Args& a, LAS unsigned char* lds, int gw, int NGW, int wave, int lane_) {
    int lane = lane_; asm volatile("" : "+v"(lane));
    unsigned char* ws = a.ws;
    LAS float* scr = (LAS float*)(lds + wave * 16384);
    for (int i = gw * 64 + lane; i < 2 * 4 * 128 * 128; i += NGW * 64) { const int s_ = i & 127, t_ = (i >> 7) & 127; ((bf16*)(ws + WS_WB))[i] = (s_ <= t_) ? (bf16)f2bf(a.in[I_GWS][i]) : (bf16)0; }
    for (int i = gw * 64 + lane; i < 2 * 4 * 64 * 64; i += NGW * 64) { const int c_ = i & 63, d_ = (i >> 6) & 63, lg = i >> 12; ((bf16*)(ws + WS_PWT))[i] = (bf16)f2bf(a.in[I_POOLW][lg * 4096 + c_ * 64 + d_]); }
    for (int i = gw * 64 + lane; i < 8 * 32768; i += NGW * 64) ((int*)(ws + WS_ROWTOK))[i] = 0;
    constexpr int N_WIN = 16 * 72, N_WOUT = 16 * 32, N_W13 = 176 * 16, N_W2 = 44 * 32, N_MW13 = 224 * 16, N_MW2 = 56 * 32;
    constexpr int TOT = 2 * N_WIN + 2 * N_WOUT + N_W13 + N_W2 + 8 * N_MW13 + 8 * N_MW2;
    for (int it = gw; it < TOT; it += NGW) {
        int r = it;
        if (r < 2 * N_WIN) { const int l = r / N_WIN; r %= N_WIN; const int kb = r / 72, nb = r % 72;
            tr_item(a.in[I_WIN] + (size_t)l * DM * DIN, DIN, 64 * kb, 32 * nb, (bf16*)(ws + WS_WIN) + (size_t)l * DIN * DM, DM, 32 * nb, 64 * kb, scr, lane); continue; }
        r -= 2 * N_WIN;
        if (r < 2 * N_WOUT) { const int l = r / N_WOUT; r %= N_WOUT; const int kb = r / 32, nb = r % 32; const int kd = 64 * kb;
            const int ks = kd < 256 ? kd : (kd < 512 ? kd + 512 : kd - 256);
            tr_item(a.in[I_WOUT] + (size_t)l * DM * DM, DM, ks, 32 * nb, (bf16*)(ws + WS_WOUT) + (size_t)l * DM * DM, DM, 32 * nb, kd, scr, lane); continue; }
        r -= 2 * N_WOUT;
        if (r < N_W13) { const int nb = r / 16, kb = r % 16; const int nd = 32 * nb, t = nd >> 8, s = (nd >> 7) & 1, j0 = nd & 127;
            tr_item(a.in[s ? I_FW3 : I_FW1], DFF, 64 * kb, 128 * t + j0, (bf16*)(ws + WS_W13), DM, nd, 64 * kb, scr, lane); continue; }
        r -= N_W13;
        if (r < N_W2) { const int kb = r / 32, nb = r % 32;
            tr_item8(a.in[I_FW2], DM, 64 * kb, 32 * nb, (unsigned char*)(ws + WS_W2), DFF, 32 * nb, 64 * kb, scr, lane); continue; }
        r -= N_W2;
        if (r < 8 * N_MW13) { const int e = r / N_MW13; r %= N_MW13; const int nb = r / 16, kb = r % 16; const int nd = 32 * nb, t = nd >> 8, s = (nd >> 7) & 1, j0 = nd & 127;
            tr_item8(a.in[s ? I_MW3 : I_MW1] + (size_t)e * DM * DFE, DFE, 64 * kb, 128 * t + j0, (unsigned char*)(ws + WS_MW13) + (size_t)e * 2 * DFE * DM, DM, nd, 64 * kb, scr, lane); continue; }
        r -= 8 * N_MW13;
        { const int e = r / N_MW2; r %= N_MW2; const int kb = r / 32, nb = r % 32;
            tr_item8(a.in[I_MW2] + (size_t)e * DFE * DM, DM, 64 * kb, 32 * nb, (unsigned char*)(ws + WS_MW2) + (size_t)e * DM * DFE, DFE, 32 * nb, 64 * kb, scr, lane); }
    }
    bf16* xb = (bf16*)(ws + WS_XB);
    for (int m0 = gw; m0 < M; m0 += 4 * NGW) {
        f32x4 xv[4][4];
#pragma unroll
        for (int k = 0; k < 4; ++k) { const f32x4* xr = (const f32x4*)(a.in[I_X] + (size_t)(m0 + k * NGW) * DM) + lane;
#pragma unroll
            for (int j = 0; j < 4; ++j) xv[k][j] = __builtin_nontemporal_load(xr + 64 * j); }
#pragma unroll
        for (int k = 0; k < 4; ++k) { u32x2* o = (u32x2*)(xb + (size_t)(m0 + k * NGW) * DM) + lane;
#pragma unroll
            for (int j = 0; j < 4; ++j) o[64 * j] = pack4(xv[k][j]); }
    }
}

__device__ __forceinline__ void chunk_unit(LAS unsigned char* lds, bf16* P, int chunk, const bf16* Wb, const float* gbs, const bf16* PwT, const float* psc) {
    typedef pg8::bf16x8 bf16x8;
    const int tid = opaque_tid(), lane = tid & 63, wv = __builtin_amdgcn_readfirstlane(tid >> 6), fr = lane & 15, fq = lane >> 4;
    const size_t r0 = (size_t)chunk * 128;
    const int tpos0 = (chunk % (SEQ / 128)) * 128;
    const int trow = 16 * wv + fr;
    {
        LAS bf16* VnT = (LAS bf16*)lds;
        const int nks = (wv >> 1) + 1;
        for (int h = 0; h < 4; ++h) {
            __syncthreads();
            {   const int sI = tid >> 2, qd = (tid & 3) * 16;
                const bf16* vp = P + (r0 + sI) * PP + PC_V + h * 64 + qd;
                const u32x4 w0 = __builtin_nontemporal_load((const u32x4*)vp), w1 = __builtin_nontemporal_load((const u32x4*)(vp + 8));
                float v[16] = {bflo(w0.x), bfhi(w0.x), bflo(w0.y), bfhi(w0.y), bflo(w0.z), bfhi(w0.z), bflo(w0.w), bfhi(w0.w),
                               bflo(w1.x), bfhi(w1.x), bflo(w1.y), bfhi(w1.y), bflo(w1.z), bfhi(w1.z), bflo(w1.w), bfhi(w1.w)};
                float sum = 0.f;
#pragma unroll
                for (int i = 0; i < 16; ++i) sum += v[i];
                sum += shx(sum, lane, 1); sum += shx(sum, lane, 2);
                const float mu = sum * (1.f / 64.f); float sq = 0.f;
#pragma unroll
                for (int i = 0; i < 16; ++i) { v[i] -= mu; sq += v[i] * v[i]; }
                sq += shx(sq, lane, 1); sq += shx(sq, lane, 2);
                const float rstd = 1.0f / sqrtf(sq * (1.f / 64.f) + LN_EPS);
#pragma unroll
                for (int i = 0; i < 16; ++i) VnT[(qd + i) * 136 + sI] = (bf16)f2bf(v[i] * rstd);
            }
            bf16x8 af[4];
#pragma unroll
            for (int ks = 0; ks < 4; ++ks) af[ks] = (ks < nks) ? *(const bf16x8*)(Wb + ((size_t)(h * 128 + trow) * 128 + 32 * ks + 8 * fq)) : (bf16x8){0, 0, 0, 0, 0, 0, 0, 0};
            __syncthreads();
            f32x4 acc[4];
#pragma unroll
            for (int j = 0; j < 4; ++j) acc[j] = (f32x4){0.f, 0.f, 0.f, 0.f};
#pragma unroll
            for (int ks = 0; ks < 4; ++ks) if (ks < nks) {
#pragma unroll
                for (int j = 0; j < 4; ++j) { const bf16x8 bfr = *(const LAS bf16x8*)(VnT + (16 * j + fr) * 136 + 32 * ks + 8 * fq);
                    acc[j] = __builtin_amdgcn_mfma_f32_16x16x32_bf16(bfr, af[ks], acc[j], 0, 0, 0); } }
            const float bias = gbs[h * 128 + trow];
#pragma unroll
            for (int j = 0; j < 4; ++j) { bf16* up = P + (r0 + trow) * PP + PC_U + h * 64 + 16 * j + 4 * fq; const u32x2 uw = *(const u32x2*)up;
                f32x4 o; o.x = bflo(uw.x) * (acc[j].x + bias); o.y = bfhi(uw.x) * (acc[j].y + bias); o.z = bflo(uw.y) * (acc[j].z + bias); o.w = bfhi(uw.y) * (acc[j].w + bias);
                *(u32x2*)up = pack4(o); }
        }
    }
    {
        LAS float* Cs = (LAS float*)lds;
        LAS bf16* Yb = (LAS bf16*)(lds + 40960);
        for (int g = 0; g < 4; ++g) {
            __syncthreads();
            for (int idx = tid; idx < 143 * 8; idx += NTHR) { const int rr = idx >> 3, c8 = (idx & 7) * 8, trel = rr - 15;
                f32x4 a = {0.f, 0.f, 0.f, 0.f}, b = {0.f, 0.f, 0.f, 0.f};
                if (tpos0 + trel >= 0) { const u32x4 w = __builtin_nontemporal_load((const u32x4*)(P + (size_t)((long)r0 + trel) * PP + PC_C + g * 64 + c8));
                    a = (f32x4){bflo(w.x), bfhi(w.x), bflo(w.y), bfhi(w.y)}; b = (f32x4){bflo(w.z), bfhi(w.z), bflo(w.w), bfhi(w.w)}; }
                *(LAS f32x4*)(Cs + rr * 64 + c8) = a; *(LAS f32x4*)(Cs + rr * 64 + c8 + 4) = b; }
            bf16x8 bfr[4][2];
#pragma unroll
            for (int j = 0; j < 4; ++j)
#pragma unroll
                for (int ks = 0; ks < 2; ++ks) bfr[j][ks] = *(const bf16x8*)(PwT + ((size_t)(g * 64 + 16 * j + fr) * 64 + 32 * ks + 8 * fq));
            __syncthreads();
            {   const int t = tid >> 2, cq = (tid & 3) * 16, win = 2 << g; const int tp = tpos0 + t; const int cnt = (tp + 1) < win ? (tp + 1) : win;
                const float rc = 1.0f / (float)cnt;
#pragma unroll
                for (int i = 0; i < 4; ++i) { f32x4 sm = {0.f, 0.f, 0.f, 0.f};
                    for (int j = 0; j < cnt; ++j) sm += *(const LAS f32x4*)(Cs + (t + 15 - j) * 64 + cq + 4 * i);
                    const f32x4 self = *(const LAS f32x4*)(Cs + (t + 15) * 64 + cq + 4 * i);
                    *(LAS u32x2*)(Yb + t * 72 + cq + 4 * i) = pack4(sm * rc - self); }
            }
            __syncthreads();
            f32x4 acc[4];
#pragma unroll
            for (int j = 0; j < 4; ++j) acc[j] = (f32x4){0.f, 0.f, 0.f, 0.f};
#pragma unroll
            for (int ks = 0; ks < 2; ++ks) { const bf16x8 af = *(const LAS bf16x8*)(Yb + trow * 72 + 32 * ks + 8 * fq);
#pragma unroll
                for (int j = 0; j < 4; ++j) acc[j] = __builtin_amdgcn_mfma_f32_16x16x32_bf16(bfr[j][ks], af, acc[j], 0, 0, 0); }
#pragma unroll
            for (int j = 0; j < 4; ++j) { const int d = 16 * j + 4 * fq; const f32x4 sc = *(const f32x4*)(psc + g * 64 + d);
                *(u32x2*)(P + (r0 + trow) * PP + PC_V + g * 64 + d) = pack4(acc[j] * sc); }
        }
    }
    __syncthreads();
}

__device__ __forceinline__ int t5_bucket(int n) {
    if (n < 16) return n;
    int v = 16 + (int)(logf((float)n * (1.0f / 16.0f)) * (16.0f / 2.0794415416798357f));
    return v < 31 ? v : 31;
}
__device__ __forceinline__ void nattn_unit(LAS unsigned char* lds, bf16* P, int b, int h, int qt, const LAS float* btab, float lam, const float* subg, float omli) {
    const int tid = opaque_tid(), row = tid >> 3, m = (tid >> 2) & 1, dq = tid & 3;
    LAS float* Ks = (LAS float*)lds;
    LAS float* Vs = Ks + 64 * 128;
    const size_t rowq = (size_t)b * SEQ + qt * 64 + row;
    float q[16];
    {   const bf16* qp = P + rowq * PP + PC_Q + h * 128 + m * 64 + dq * 16;
#pragma unroll
        for (int i = 0; i < 2; ++i) { const u32x4 v = *(const u32x4*)(qp + 8 * i);
            q[8 * i] = bflo(v.x); q[8 * i + 1] = bfhi(v.x); q[8 * i + 2] = bflo(v.y); q[8 * i + 3] = bfhi(v.y); q[8 * i + 4] = bflo(v.z); q[8 * i + 5] = bfhi(v.z); q[8 * i + 6] = bflo(v.w); q[8 * i + 7] = bfhi(v.w); } }
    float o[32];
#pragma unroll
    for (int d = 0; d < 32; ++d) o[d] = 0.f;
    float mr = -INFINITY, l = 0.f;
    const int qpos = qt * 64 + row;
    for (int kt = 0; kt <= qt; ++kt) {
        __syncthreads();
        {   const int key = tid >> 3, c16 = (tid & 7) * 16;
            const bf16* kp = P + ((size_t)b * SEQ + kt * 64 + key) * PP + PC_K + h * 128 + c16;
            const u32x4 k0 = *(const u32x4*)kp, k1 = *(const u32x4*)(kp + 8), v0 = *(const u32x4*)(kp + 512), v1 = *(const u32x4*)(kp + 520);
            LAS float* kd = Ks + key * 128 + c16; LAS float* vd = Vs + key * 128 + c16;
            *(LAS f32x4*)(kd) = (f32x4){bflo(k0.x), bfhi(k0.x), bflo(k0.y), bfhi(k0.y)}; *(LAS f32x4*)(kd + 4) = (f32x4){bflo(k0.z), bfhi(k0.z), bflo(k0.w), bfhi(k0.w)};
            *(LAS f32x4*)(kd + 8) = (f32x4){bflo(k1.x), bfhi(k1.x), bflo(k1.y), bfhi(k1.y)}; *(LAS f32x4*)(kd + 12) = (f32x4){bflo(k1.z), bfhi(k1.z), bflo(k1.w), bfhi(k1.w)};
            *(LAS f32x4*)(vd) = (f32x4){bflo(v0.x), bfhi(v0.x), bflo(v0.y), bfhi(v0.y)}; *(LAS f32x4*)(vd + 4) = (f32x4){bflo(v0.z), bfhi(v0.z), bflo(v0.w), bfhi(v0.w)};
            *(LAS f32x4*)(vd + 8) = (f32x4){bflo(v1.x), bfhi(v1.x), bflo(v1.y), bfhi(v1.y)}; *(LAS f32x4*)(vd + 12) = (f32x4){bflo(v1.z), bfhi(v1.z), bflo(v1.w), bfhi(v1.w)};
        }
        __syncthreads();
        const int kbase = kt * 64;
        for (int j0 = 0; j0 < 64; j0 += 4) {
            float s[4];
#pragma unroll
            for (int jj = 0; jj < 4; ++jj) { const LAS float* kr = Ks + (j0 + jj) * 128 + m * 64 + dq * 16; float a = 0.f;
#pragma unroll
                for (int d = 0; d < 16; d += 4) { const f32x4 kv = *(const LAS f32x4*)(kr + d); a += q[d] * kv.x + q[d + 1] * kv.y + q[d + 2] * kv.z + q[d + 3] * kv.w; }
                a += __shfl_xor(a, 1); a += __shfl_xor(a, 2); s[jj] = a; }
            float gm = mr;
#pragma unroll
            for (int jj = 0; jj < 4; ++jj) { const int dist = qpos - (kbase + j0 + jj);
                if (dist < 0) s[jj] = -INFINITY; else if (dist < 128) s[jj] += btab[dist];
                gm = fmaxf(gm, s[jj]); }
            const float sc = __builtin_amdgcn_exp2f(mr - gm);
            mr = gm; l *= sc;
#pragma unroll
            for (int d = 0; d < 32; ++d) o[d] *= sc;
#pragma unroll
            for (int jj = 0; jj < 4; ++jj) { const float pj = __builtin_amdgcn_exp2f(s[jj] - gm); l += pj;
                const LAS float* vr = Vs + (j0 + jj) * 128 + dq * 32;
#pragma unroll
                for (int d = 0; d < 32; d += 4) { const f32x4 vv = *(const LAS f32x4*)(vr + d); o[d] += pj * vv.x; o[d + 1] += pj * vv.y; o[d + 2] += pj * vv.z; o[d + 3] += pj * vv.w; } }
        }
    }
    {   const float rl = 1.0f / l; float ss = 0.f;
#pragma unroll
        for (int d = 0; d < 32; ++d) { const float y = o[d] * rl; const float oth = __shfl_xor(y, 4); o[d] = y - lam * oth; ss += o[d] * o[d]; }
        ss += __shfl_xor(ss, 1); ss += __shfl_xor(ss, 2);
        const float rs = (1.0f / sqrtf(ss * (1.f / 128.f) + LN_EPS)) * omli;
        if (m == 0) {
            bf16* yp = P + rowq * PP + PC_Q + h * 128 + dq * 32; const float* gp = subg + dq * 32;
#pragma unroll
            for (int i = 0; i < 4; ++i) { u32x4 w;
                w.x = pk2(o[8 * i] * rs * gp[8 * i], o[8 * i + 1] * rs * gp[8 * i + 1]); w.y = pk2(o[8 * i + 2] * rs * gp[8 * i + 2], o[8 * i + 3] * rs * gp[8 * i + 3]);
                w.z = pk2(o[8 * i + 4] * rs * gp[8 * i + 4], o[8 * i + 5] * rs * gp[8 * i + 5]); w.w = pk2(o[8 * i + 6] * rs * gp[8 * i + 6], o[8 * i + 7] * rs * gp[8 * i + 7]);
                *(u32x4*)(yp + 8 * i) = w; }
        }
    }
    __syncthreads();
}

#include <hip/hip_bf16.h>
#include <cmath>
namespace attn_body {
using bf16=__hip_bfloat16;
using bf16x8=__attribute__((ext_vector_type(8)))short;
using s16x4=__attribute__((ext_vector_type(4)))short;
using f32x16=__attribute__((ext_vector_type(16)))float;
using u32x4=__attribute__((ext_vector_type(4)))unsigned;
constexpr int SEQ=16384,D=64;
constexpr int NW=8,QBLK=32,QB=QBLK*NW,KVBLK=64,NQB=SEQ/QB;
constexpr int PQ=2304,PO=1024,ATTN_UNIT_ROWS=QB;
__device__ __forceinline__ int crow(int r,int hi){return (r&3)+8*(r>>2)+4*hi;}
#define SBAR() __builtin_amdgcn_sched_barrier(0)
__device__ __forceinline__ void cmask(f32x16&p0,f32x16&p1,int jb,int qrel,int hi){
  const float NEG=-INFINITY; int kb=64*jb+4*hi;
  #pragma unroll
  for(int r=0;r<16;++r){int kv=kb+(r&3)+8*(r>>2); if(kv>qrel)p0[r]=NEG; if(kv+32>qrel)p1[r]=NEG;}
}

constexpr int NSLOT=3, SLOTB=8192;
constexpr int LDS_K=0, LDS_V=NSLOT*SLOTB, LDS_WS=2*NSLOT*SLOTB, LDS_OST=LDS_WS+NW*64*4, LDS_BYTES=LDS_OST+NW*4096;
constexpr float C2=0.125f*1.4426950408889634f;
__device__ __forceinline__ void glds16(const void*gsrc,unsigned lds_dst){unsigned keep;
  asm volatile("s_mov_b32 %0, m0\n\ts_mov_b32 m0, %2\n\ts_nop 0\n\tglobal_load_lds_dwordx4 %1, off\n\ts_mov_b32 m0, %0":"=&s"(keep):"v"(gsrc),"s"(lds_dst):"memory");}
__device__ __forceinline__ float max3f(float a,float b,float c){float r;asm("v_max3_f32 %0, %1, %2, %3":"=v"(r):"v"(a),"v"(b),"v"(c));return r;}
__device__ __forceinline__ float max2f(float a,float b){float r;asm("v_max_f32_e32 %0, %1, %2":"=v"(r):"v"(a),"v"(b));return r;}
__device__ __forceinline__ float fadd_s(float a,float b){float r;asm("v_add_f32_e32 %0, %1, %2":"=v"(r):"v"(a),"v"(b));return r;}
__device__ __forceinline__ float fsub_s(float a,float b){float r;asm("v_sub_f32_e32 %0, %1, %2":"=v"(r):"v"(a),"v"(b));return r;}
__device__ __forceinline__ float fmul_s(float a,float b){float r;asm("v_mul_f32_e32 %0, %1, %2":"=v"(r):"v"(a),"v"(b));return r;}
typedef float f32x2_t __attribute__((ext_vector_type(2))); typedef __bf16 bf16x2_t __attribute__((ext_vector_type(2)));
__device__ __forceinline__ unsigned cvtpk_s(float lo,float hi){f32x2_t v={lo,hi};bf16x2_t b=__builtin_convertvector(v,bf16x2_t);return __builtin_bit_cast(unsigned,b);}
#define WAIT_BAR(N) asm volatile("s_waitcnt vmcnt(" #N ") lgkmcnt(0)\n\ts_barrier":::"memory")

__device__ __forceinline__ void qkt(f32x16&p0,f32x16&p1,const char*Kslot,const bf16x8*qr,const f32x16&negm,int r32,int hi){
  const char*kb=Kslot+hi*1024+r32*16;
  #pragma unroll
  for(int d0=0;d0<4;++d0){
    const bf16x8 b0=*reinterpret_cast<const bf16x8*>(kb+d0*2048);
    const bf16x8 b1=*reinterpret_cast<const bf16x8*>(kb+d0*2048+512);
    if(d0==0){p0=__builtin_amdgcn_mfma_f32_32x32x16_bf16(b0,qr[0],negm,0,0,0);p1=__builtin_amdgcn_mfma_f32_32x32x16_bf16(b1,qr[0],negm,0,0,0);}
    else{p0=__builtin_amdgcn_mfma_f32_32x32x16_bf16(b0,qr[d0],p0,0,0,0);p1=__builtin_amdgcn_mfma_f32_32x32x16_bf16(b1,qr[d0],p1,0,0,0);}}
}
typedef __attribute__((address_space(3))) const char* lds_cptr;
typedef short v4i16_t __attribute__((ext_vector_type(4)));
__device__ __forceinline__ void kload8(bf16x8*kf,lds_cptr kp){
  kf[0]=*(const __attribute__((address_space(3))) bf16x8*)(kp);      kf[1]=*(const __attribute__((address_space(3))) bf16x8*)(kp+512);
  kf[2]=*(const __attribute__((address_space(3))) bf16x8*)(kp+2048); kf[3]=*(const __attribute__((address_space(3))) bf16x8*)(kp+2560);
  kf[4]=*(const __attribute__((address_space(3))) bf16x8*)(kp+4096); kf[5]=*(const __attribute__((address_space(3))) bf16x8*)(kp+4608);
  kf[6]=*(const __attribute__((address_space(3))) bf16x8*)(kp+6144); kf[7]=*(const __attribute__((address_space(3))) bf16x8*)(kp+6656);
}
__device__ __forceinline__ void kload2(bf16x8*kf,lds_cptr kp,int j){ kf[2*j]=*(const __attribute__((address_space(3))) bf16x8*)(kp+j*2048); kf[2*j+1]=*(const __attribute__((address_space(3))) bf16x8*)(kp+j*2048+512); }
__device__ __forceinline__ s16x4 vtr(lds_cptr p){ return __builtin_bit_cast(s16x4,__builtin_amdgcn_ds_read_tr16_b64_v4i16((__attribute__((address_space(3))) v4i16_t*)p)); }
__device__ __forceinline__ float rowmax(const f32x16&p0,const f32x16&p1){
  float a=max3f(p0[0],p0[1],p1[0]),b=max3f(p0[2],p0[3],p1[1]);a=max3f(a,p1[2],p1[3]);
  #pragma unroll
  for(int r=4;r<16;r+=4){a=max3f(a,p0[r],p0[r+1]);b=max3f(b,p0[r+2],p0[r+3]);a=max3f(a,p1[r],p1[r+1]);b=max3f(b,p1[r+2],p1[r+3]);}
  const float m=max2f(a,b);
  auto rr=__builtin_amdgcn_permlane32_swap(__float_as_uint(m),__float_as_uint(m),false,false);
  return max2f(__uint_as_float(rr[0]),__uint_as_float(rr[1]));
}
__device__ __forceinline__ void pv(f32x16*o,int vb,bf16x8 pa0,bf16x8 pa1,bf16x8 pa2,bf16x8 pa3){
  #pragma unroll
  for(int d0=0;d0<2;++d0){s16x4 lo[4],hi[4];
    #pragma unroll
    for(int ks=0;ks<4;++ks){
      asm volatile("ds_read_b64_tr_b16 %0,%1 offset:%c2":"=&v"(lo[ks]):"v"(vb),"i"(d0*4096+ks*1024):"memory");
      asm volatile("ds_read_b64_tr_b16 %0,%1 offset:%c2":"=&v"(hi[ks]):"v"(vb),"i"(d0*4096+ks*1024+512):"memory");}
    asm volatile("s_waitcnt lgkmcnt(0)":::"memory");SBAR();
    #define PK(k) (bf16x8){lo[k][0],lo[k][1],lo[k][2],lo[k][3],hi[k][0],hi[k][1],hi[k][2],hi[k][3]}
    o[d0]=__builtin_amdgcn_mfma_f32_32x32x16_bf16(pa0,PK(0),o[d0],0,0,0);
    o[d0]=__builtin_amdgcn_mfma_f32_32x32x16_bf16(pa1,PK(1),o[d0],0,0,0);
    o[d0]=__builtin_amdgcn_mfma_f32_32x32x16_bf16(pa2,PK(2),o[d0],0,0,0);
    o[d0]=__builtin_amdgcn_mfma_f32_32x32x16_bf16(pa3,PK(3),o[d0],0,0,0);
    #undef PK
  }
}

#ifndef ATTN_STORE16
#define ATTN_STORE16(p,v) __builtin_nontemporal_store((v),(u32x4*)(p))
#endif
template<int THRL> __device__ __forceinline__ void attn_unit(int b,int qb,const bf16*Q,const bf16*__restrict__ K,const bf16*__restrict__ V,bf16*O,const __attribute__((address_space(3))) float*xtab,char*shm){
  int tid=threadIdx.x; asm volatile("":"+v"(tid)); asm volatile("":"+s"(qb)); asm volatile("":"+s"(b));
  const int lane=tid&63,r32=lane&31,hi=lane>>5; const int wid=__builtin_amdgcn_readfirstlane(tid>>6);
  const long rowbase=(long)b*SEQ; const int q0=qb*QB;
  const bf16*Qw=Q+(rowbase+q0+wid*QBLK)*PQ;
  const bf16*Kh=K+rowbase*PQ,*Vh=V+rowbase*PQ;
  const unsigned lds0=(unsigned)(uintptr_t)shm;
  float*wsf=(float*)(shm+LDS_WS)+wid*64;
  const bf16*ksrc=Kh+(long)lane*PQ+wid*8;
  const bf16*vsrc=Vh+(long)(16*(wid&3)+(lane>>2))*PQ+(wid>>2)*32+(lane&3)*8;
  const unsigned kdst=lds0+LDS_K+wid*1024, vdst=lds0+LDS_V+wid*1024;
  #define DMA_K(t,slot) glds16(ksrc+(long)(t)*KVBLK*PQ,(unsigned)__builtin_amdgcn_readfirstlane(kdst+(slot)))
  #define DMA_V(t,slot) glds16(vsrc+(long)(t)*KVBLK*PQ,(unsigned)__builtin_amdgcn_readfirstlane(vdst+(slot)))
  const int vb0=(int)(lds0+LDS_V)+((lane>>4)&1)*32+(lane&3)*8+(4*hi+((lane&15)>>2))*64;
  const char*Kbase=shm+LDS_K; bf16x8 kf[8];
  const lds_cptr shm3=(lds_cptr)shm; const lds_cptr kp0=shm3+LDS_K+hi*1024+r32*16; const lds_cptr vp0=shm3+LDS_V+((lane>>4)&1)*32+(lane&3)*8+(4*hi+((lane&15)>>2))*64;
  const int NT=(q0+QB)/KVBLK;
  DMA_K(0,0);DMA_V(0,0);DMA_K(1,SLOTB);
  bf16x8 qr[4];
  #pragma unroll
  for(int d0=0;d0<4;++d0)qr[d0]=*reinterpret_cast<const bf16x8*>(&Qw[(long)r32*PQ+d0*16+hi*8]);
  float mhat=0.f,l_reg=0.f;f32x16 o[2];o[0]=f32x16{};o[1]=f32x16{};f32x16 negm=f32x16{};asm volatile("":"+v"(negm));
  const int qrel=wid*QBLK+r32;
  #define CMASK(P0,P1,t) do{int jb_=(t)-(NT-4); if(jb_>=0)cmask(P0,P1,jb_,qrel,hi);}while(0)
  #define CBIAS_ON(P0,P1,t) do{ if((t)>=NT-6){ const __attribute__((address_space(3))) float*tb_=xtab+(q0+qrel-64*(t)-4*hi+(256-59)); \
      _Pragma("unroll") for(int g_=0;g_<4;++g_){ float b0_[4],b1_[4]; \
        _Pragma("unroll") for(int i_=0;i_<4;++i_){ b0_[i_]=tb_[59-(i_+8*g_)]; b1_[i_]=tb_[27-(i_+8*g_)]; } \
        _Pragma("unroll") for(int i_=0;i_<4;++i_){ P0[4*g_+i_]=fadd_s(P0[4*g_+i_],b0_[i_]); P1[4*g_+i_]=fadd_s(P1[4*g_+i_],b1_[i_]); } \
        asm volatile("":"+v"(P0),"+v"(P1)); SBAR(); } } }while(0)
  #define CBIAS(P0,P1,t) CBIAS_ON(P0,P1,t)
  bool resc=false;
  #define START(P0,P1) do{ const float rm=rowmax(P0,P1); resc=false; \
    { const float dl=rm; mhat=fadd_s(mhat,dl); \
      _Pragma("unroll") for(int r=0;r<16;++r){P0[r]=fsub_s(P0[r],dl);P1[r]=fsub_s(P1[r],dl);} \
      _Pragma("unroll") for(int r=0;r<16;++r)negm[r]=-mhat; asm volatile("":"+v"(negm)); } \
    _Pragma("unroll") for(int r=0;r<16;++r)P0[r]=__builtin_amdgcn_exp2f(P0[r]); }while(0)
  #define RESC() do{ if(resc){ asm volatile("s_waitcnt lgkmcnt(0)":::"memory"); \
      _Pragma("unroll") for(int d_=0;d_<2;++d_) _Pragma("unroll") for(int r=0;r<16;++r)o[d_][r]*=wsf[crow(r,hi)]; } }while(0)
  f32x16 pA0,pA1,pB0,pB1;
  int sl_prev=0,sl_cur=0,sl_next=SLOTB;
  #define ROT() do{sl_prev=sl_cur;sl_cur=sl_next;sl_next=(sl_next==(NSLOT-1)*SLOTB)?0:sl_next+SLOTB;}while(0)
  DMA_K(2,2*SLOTB);
  WAIT_BAR(3);
  qkt(pA0,pA1,Kbase,qr,negm,r32,hi);asm volatile("s_nop 15\n\ts_nop 7":"+v"(pA0),"+v"(pA1));CMASK(pA0,pA1,0);CBIAS(pA0,pA1,0);
  START(pA0,pA1);
  _Pragma("unroll") for(int r=0;r<16;++r)pA1[r]=__builtin_amdgcn_exp2f(pA1[r]);
  WAIT_BAR(0);
  DMA_K(3,0);DMA_V(1,SLOTB);
  ROT();
  kload8(kf,kp0+sl_cur);
  WAIT_BAR(2);
  s16x4 vlo[8],vhi[8]; u32x4 pw0,pw1,pw2,pw3;
  #define PKW(P,B) cvtpk_s(P[B],P[B+1])
  #define PAF(k) __builtin_bit_cast(bf16x8,pw##k)
  #define VFR(i) (bf16x8){vlo[i][0],vlo[i][1],vlo[i][2],vlo[i][3],vhi[i][0],vhi[i][1],vhi[i][2],vhi[i][3]}
  #define PIN(x) asm volatile("":"+v"(x))
  #define MX3(a,b,c) __builtin_fmaxf(__builtin_fmaxf((a),(b)),(c))
  #define GAPA(MF,A0,A1,A2,A3,W0,W1,PW) do{ MF; sacc+=A0; sacc+=A1; sacc+=A2; sacc+=A3; PIN(sacc); W0; W1; PIN(PW); SBAR(); }while(0)
  #define EX(v) __builtin_amdgcn_exp2f(v)
  #define GAPB(MF,X,B) do{ MF; X[B]=EX(X[B]); X[B+1]=EX(X[B+1]); X[B+2]=EX(X[B+2]); X[B+3]=EX(X[B+3]); PIN(X); SBAR(); }while(0)
  #define VRD(i) do{ vlo[i]=vtr(vp_+(((i)>>2)*4096+((i)&3)*1024)); vhi[i]=vtr(vp_+(((i)>>2)*4096+((i)&3)*1024+512)); }while(0)
  #define KRD(G,j) do{ if(G){ kload2(kf,kp0+sl_next,j); SBAR(); } }while(0)
  #define STEP(C0,C1,P0,P1,t,GK,GV,GL) do{ SBAR(); \
    const lds_cptr vp_=vp0+sl_prev; \
    VRD(0); SBAR(); float sacc=(P0[0]+P0[1]); \
    GAPA(C0=__builtin_amdgcn_mfma_f32_32x32x16_bf16(kf[0],qr[0],negm,0,0,0), P0[2],P0[3],P0[4],P0[5],     pw0[0]=PKW(P0,0), pw0[1]=PKW(P0,2), pw0); \
    VRD(4); SBAR(); GAPA(C1=__builtin_amdgcn_mfma_f32_32x32x16_bf16(kf[1],qr[0],negm,0,0,0), P0[6],P0[7],P0[8],P0[9],     pw0[2]=PKW(P0,4), pw0[3]=PKW(P0,6), pw0); \
    VRD(1); SBAR(); GAPA(C0=__builtin_amdgcn_mfma_f32_32x32x16_bf16(kf[2],qr[1],C0,0,0,0),   P0[10],P0[11],P0[12],P0[13], pw1[0]=PKW(P0,8), pw1[1]=PKW(P0,10), pw1); \
    VRD(5); SBAR(); GAPA(C1=__builtin_amdgcn_mfma_f32_32x32x16_bf16(kf[3],qr[1],C1,0,0,0),   P0[14],P0[15],P1[0],P1[1],   pw1[2]=PKW(P0,12),pw1[3]=PKW(P0,14), pw1); \
    VRD(2); SBAR(); GAPA(C0=__builtin_amdgcn_mfma_f32_32x32x16_bf16(kf[4],qr[2],C0,0,0,0),   P1[2],P1[3],P1[4],P1[5],     pw2[0]=PKW(P1,0), pw2[1]=PKW(P1,2), pw2); \
    VRD(6); SBAR(); GAPA(C1=__builtin_amdgcn_mfma_f32_32x32x16_bf16(kf[5],qr[2],C1,0,0,0),   P1[6],P1[7],P1[8],P1[9],     pw2[2]=PKW(P1,4), pw2[3]=PKW(P1,6), pw2); \
    VRD(3); SBAR(); GAPA(C0=__builtin_amdgcn_mfma_f32_32x32x16_bf16(kf[6],qr[3],C0,0,0,0),   P1[10],P1[11],P1[12],P1[13], pw3[0]=PKW(P1,8), pw3[1]=PKW(P1,10), pw3); \
    VRD(7); SBAR(); GAPA(C1=__builtin_amdgcn_mfma_f32_32x32x16_bf16(kf[7],qr[3],C1,0,0,0),   P1[14],P1[15],0.f,0.f,       pw3[2]=PKW(P1,12),pw3[3]=PKW(P1,14), pw3); \
    l_reg+=sacc; \
    if(GK){DMA_K((t)+3,sl_cur);} if(GV){DMA_V((t)+1,sl_next);} \
    CMASK(C0,C1,t); CBIAS(C0,C1,t); \
    { float a=MX3(C0[0],C0[1],C1[0]),b=MX3(C0[2],C0[3],C1[1]); a=MX3(a,C1[2],C1[3]); \
      _Pragma("unroll") for(int r=4;r<16;r+=4){a=MX3(a,C0[r],C0[r+1]);b=MX3(b,C0[r+2],C0[r+3]);a=MX3(a,C1[r],C1[r+1]);b=MX3(b,C1[r+2],C1[r+3]);} \
      float rm=__builtin_fmaxf(a,b); { auto rr=__builtin_amdgcn_permlane32_swap(__float_as_uint(rm),__float_as_uint(rm),false,false); rm=__builtin_fmaxf(__uint_as_float(rr[0]),__uint_as_float(rr[1])); } \
      resc=false; \
      if(__builtin_expect(__any(rm>(float)THRL),0)){ const float dl=__builtin_fmaxf(rm,0.f); mhat+=dl; \
        _Pragma("unroll") for(int r=0;r<16;++r){C0[r]-=dl;C1[r]-=dl;} \
        _Pragma("unroll") for(int r=0;r<16;++r)negm[r]=-mhat; asm volatile("":"+v"(negm)); \
        const float f=__builtin_amdgcn_exp2f(-dl); l_reg*=f; if(hi==0)wsf[r32]=f; resc=true; } } \
    SBAR(); \
    GAPB(o[0]=__builtin_amdgcn_mfma_f32_32x32x16_bf16(PAF(0),VFR(0),o[0],0,0,0), C0,0); \
    GAPB(o[1]=__builtin_amdgcn_mfma_f32_32x32x16_bf16(PAF(0),VFR(4),o[1],0,0,0), C0,4); \
    KRD(GL,0); GAPB(o[0]=__builtin_amdgcn_mfma_f32_32x32x16_bf16(PAF(1),VFR(1),o[0],0,0,0), C0,8); \
    KRD(GL,1); GAPB(o[1]=__builtin_amdgcn_mfma_f32_32x32x16_bf16(PAF(1),VFR(5),o[1],0,0,0), C0,12); \
    KRD(GL,2); GAPB(o[0]=__builtin_amdgcn_mfma_f32_32x32x16_bf16(PAF(2),VFR(2),o[0],0,0,0), C1,0); \
    KRD(GL,3); GAPB(o[1]=__builtin_amdgcn_mfma_f32_32x32x16_bf16(PAF(2),VFR(6),o[1],0,0,0), C1,4); \
    GAPB(o[0]=__builtin_amdgcn_mfma_f32_32x32x16_bf16(PAF(3),VFR(3),o[0],0,0,0), C1,8); \
    GAPB(o[1]=__builtin_amdgcn_mfma_f32_32x32x16_bf16(PAF(3),VFR(7),o[1],0,0,0), C1,12); \
    }while(0)
  int t=1;
  #undef CMASK
  #undef CBIAS
  #define CMASK(P0,P1,t) do{}while(0)
  #define CBIAS(P0,P1,t) do{}while(0)
  for(;t+7<NT;t+=2){
    STEP(pB0,pB1,pA0,pA1,t,true,true,true);     WAIT_BAR(2); RESC(); ROT();
    STEP(pA0,pA1,pB0,pB1,t+1,true,true,true);   WAIT_BAR(2); RESC(); ROT();
  }
  #undef CMASK
  #undef CBIAS
  #define CMASK(P0,P1,t) do{int jb_=(t)-(NT-4); if(jb_>=0)cmask(P0,P1,jb_,qrel,hi);}while(0)
  #define CBIAS(P0,P1,t) CBIAS_ON(P0,P1,t)
  #define ENDW(tt) do{ if((tt)+3<NT){WAIT_BAR(2);} else if((tt)+2<NT){WAIT_BAR(1);} else {WAIT_BAR(0);} }while(0)
  for(;t+1<NT;t+=2){
    STEP(pB0,pB1,pA0,pA1,t,(t+3<NT),(t+1<NT),(t+1<NT));       ENDW(t);   RESC(); ROT();
    STEP(pA0,pA1,pB0,pB1,t+1,(t+4<NT),(t+2<NT),(t+2<NT));     ENDW(t+1); RESC(); ROT();
  }
  STEP(pB0,pB1,pA0,pA1,NT-1,false,false,false); RESC();
  { float sacc=pB0[0]+pB0[1]; _Pragma("unroll") for(int r=2;r<16;++r)sacc+=pB0[r]; _Pragma("unroll") for(int r=0;r<16;++r)sacc+=pB1[r]; l_reg+=sacc;
    pw0=(u32x4){PKW(pB0,0),PKW(pB0,2),PKW(pB0,4),PKW(pB0,6)};pw1=(u32x4){PKW(pB0,8),PKW(pB0,10),PKW(pB0,12),PKW(pB0,14)};pw2=(u32x4){PKW(pB1,0),PKW(pB1,2),PKW(pB1,4),PKW(pB1,6)};pw3=(u32x4){PKW(pB1,8),PKW(pB1,10),PKW(pB1,12),PKW(pB1,14)};
    SBAR(); pv(o,vb0+sl_cur,PAF(0),PAF(1),PAF(2),PAF(3)); }
  #undef PKW
  #undef PAF
  #undef VFR
  #undef PIN
  #undef MX3
  #undef GAPA
  #undef GAPB
  #undef EX
  #undef VRD
  #undef KRD
  #undef STEP
  #undef ENDW
  {auto rr=__builtin_amdgcn_permlane32_swap(__float_as_uint(l_reg),__float_as_uint(l_reg),false,false);l_reg=__uint_as_float(rr[0])+__uint_as_float(rr[1]);}
  if(hi==0)wsf[32+r32]=l_reg;asm volatile("s_waitcnt lgkmcnt(0)":::"memory");
  float rli[16];
  #pragma unroll
  for(int r=0;r<16;++r)rli[r]=__builtin_amdgcn_rcpf(wsf[32+crow(r,hi)]);
  bf16*Ow=O+(rowbase+q0+wid*QBLK)*PO;
  { bf16*stg=(bf16*)(shm+LDS_OST)+wid*2048;
    #pragma unroll
    for(int r=0;r<16;++r){const int orow=crow(r,hi);
      #pragma unroll
      for(int d0=0;d0<2;++d0)stg[orow*64+d0*32+r32]=__float2bfloat16(o[d0][r]*rli[r]);}
    asm volatile("s_waitcnt lgkmcnt(0)":::"memory");
    #pragma unroll
    for(int i=0;i<4;++i){const int row=i*8+(lane>>3),ch=lane&7; const u32x4 v=*(const u32x4*)(stg+row*64+ch*8); ATTN_STORE16(Ow+(long)row*PO+ch*8,v);} }
  asm volatile("s_waitcnt lgkmcnt(0)\n\ts_barrier":::"memory");
  #undef DMA_K
  #undef DMA_V
  #undef CMASK
  #undef CBIAS
  #undef CBIAS_ON
  #undef START
  #undef RESC
  #undef ROT
}

constexpr int VSLOT=16384, NSLOTV=4, L2_K=0, L2_V=NSLOT*SLOTB, L2_WS=L2_V+NSLOTV*VSLOT, L2_OST=L2_WS+NW*64*4, L2_BYTES=L2_OST+NW*4096;
template<int THRL> __device__ __forceinline__ void attn_unit2(int b,int qb,const bf16*Q,const bf16*__restrict__ K,const bf16*__restrict__ V,bf16*O,const __attribute__((address_space(3))) float*xtab,char*shm){
  int tid=threadIdx.x; asm volatile("":"+v"(tid)); asm volatile("":"+s"(qb)); asm volatile("":"+s"(b));
  const int lane=tid&63,r32=lane&31,hi=lane>>5; const int wid=__builtin_amdgcn_readfirstlane(tid>>6);
  const long rowbase=(long)b*SEQ; const int q0=qb*QB;
  const bf16*Qw=Q+(rowbase+q0+wid*QBLK)*PQ;
  const bf16*Kh=K+rowbase*PQ,*Vh=V+rowbase*PQ;
  const unsigned lds0=(unsigned)(uintptr_t)shm;
  float*wsf=(float*)(shm+L2_WS)+wid*64;
  const bf16*ksrc=Kh+(long)lane*PQ+wid*8;
  const bf16*vsrc=Vh+(long)(16*(wid&3)+(lane>>2))*PQ+(wid>>2)*32+(lane&3)*8;
  const unsigned kdst=lds0+L2_K+wid*1024, vdst=lds0+L2_V+wid*1024;
  #define DMA_K(t,slot) glds16(ksrc+(long)(t)*KVBLK*PQ,(unsigned)__builtin_amdgcn_readfirstlane(kdst+(slot)))
  #define DMA_V(t,voff) do{ glds16(vsrc+(long)(t)*KVBLK*PQ,(unsigned)__builtin_amdgcn_readfirstlane(vdst+(voff))); glds16(vsrc+64+(long)(t)*KVBLK*PQ,(unsigned)__builtin_amdgcn_readfirstlane(vdst+(voff)+8192)); }while(0)
  const int vb0=(int)(lds0+L2_V)+((lane>>4)&1)*32+(lane&3)*8+(4*hi+((lane&15)>>2))*64;
  const char*Kbase=shm+L2_K; bf16x8 kf[8];
  const lds_cptr shm3=(lds_cptr)shm; const lds_cptr kp0=shm3+L2_K+hi*1024+r32*16; const lds_cptr vp0=shm3+L2_V+((lane>>4)&1)*32+(lane&3)*8+(4*hi+((lane&15)>>2))*64;
  const int NT=(q0+QB)/KVBLK;
  DMA_K(0,0);DMA_V(0,0);DMA_K(1,SLOTB);
  bf16x8 qr[4];
  #pragma unroll
  for(int d0=0;d0<4;++d0)qr[d0]=__builtin_nontemporal_load(reinterpret_cast<const bf16x8*>(&Qw[(long)r32*PQ+d0*16+hi*8]));
  float mhat=0.f,l_reg=0.f;f32x16 o[4];o[0]=f32x16{};o[1]=f32x16{};o[2]=f32x16{};o[3]=f32x16{};
  const int qrel=wid*QBLK+r32;
  #define CMASK(P0,P1,t) do{int jb_=(t)-(NT-4); if(jb_>=0)cmask(P0,P1,jb_,qrel,hi);}while(0)
  #define CBIAS_ON(P0,P1,t) do{ if((t)>=NT-6){ const __attribute__((address_space(3))) float*tb_=xtab+(q0+qrel-64*(t)-4*hi+(256-59)); \
      _Pragma("unroll") for(int g_=0;g_<4;++g_){ float b0_[4],b1_[4]; \
        _Pragma("unroll") for(int i_=0;i_<4;++i_){ b0_[i_]=tb_[59-(i_+8*g_)]; b1_[i_]=tb_[27-(i_+8*g_)]; } \
        _Pragma("unroll") for(int i_=0;i_<4;++i_){ P0[4*g_+i_]=fadd_s(P0[4*g_+i_],b0_[i_]); P1[4*g_+i_]=fadd_s(P1[4*g_+i_],b1_[i_]); } \
        asm volatile("":"+v"(P0),"+v"(P1)); SBAR(); } } }while(0)
  #define CBIAS(P0,P1,t) CBIAS_ON(P0,P1,t)
  bool resc=false;
  #define START(P0,P1) do{ const float rm=rowmax(P0,P1); resc=false; \
    { const float dl=rm; mhat=fadd_s(mhat,dl); \
      _Pragma("unroll") for(int r=0;r<16;++r){P0[r]=fsub_s(P0[r],dl);P1[r]=fsub_s(P1[r],dl);} \
      } \
    _Pragma("unroll") for(int r=0;r<16;++r)P0[r]=__builtin_amdgcn_exp2f(P0[r]); }while(0)
  #define RESC() do{ if(resc){ asm volatile("s_waitcnt lgkmcnt(0)":::"memory"); \
      _Pragma("unroll") for(int r=0;r<16;++r){ const float f_=wsf[crow(r,hi)]; _Pragma("unroll") for(int d_=0;d_<4;++d_) o[d_][r]=fmul_s(o[d_][r],f_); } } }while(0)
  f32x16 c0,c1; f32x16 negm;
  int sl_prev=0,sl_cur=0,sl_next=SLOTB; int vs_prev=0,vs_dma=3*VSLOT;
  #define ROT() do{sl_prev=sl_cur;sl_cur=sl_next;sl_next=(sl_next==(NSLOT-1)*SLOTB)?0:sl_next+SLOTB; vs_prev=(vs_prev+VSLOT)&(NSLOTV*VSLOT-1); vs_dma=(vs_dma+VSLOT)&(NSLOTV*VSLOT-1);}while(0)
  DMA_K(2,2*SLOTB);DMA_V(1,VSLOT);
  WAIT_BAR(6);
  s16x4 vlo[8],vhi[8]; u32x4 pw0,pw1,pw2,pw3;
  #define PKW(P,B) cvtpk_s(P[B],P[B+1])
  #define PAF(k) __builtin_bit_cast(bf16x8,pw##k)
  { const f32x16 zero16=f32x16{}; qkt(c0,c1,Kbase,qr,zero16,r32,hi); }asm volatile("s_nop 15\n\ts_nop 7":"+v"(c0),"+v"(c1));CMASK(c0,c1,0);CBIAS(c0,c1,0);
  START(c0,c1);
  { const float nm_=-mhat; _Pragma("unroll") for(int r=0;r<16;++r)negm[r]=nm_; }
  _Pragma("unroll") for(int r=0;r<16;++r)c1[r]=__builtin_amdgcn_exp2f(c1[r]);
  { float sacc=c0[0]+c0[1]; _Pragma("unroll") for(int r=2;r<16;++r)sacc+=c0[r]; _Pragma("unroll") for(int r=0;r<16;++r)sacc+=c1[r]; l_reg+=sacc;
    pw0=(u32x4){PKW(c0,0),PKW(c0,2),PKW(c0,4),PKW(c0,6)};pw1=(u32x4){PKW(c0,8),PKW(c0,10),PKW(c0,12),PKW(c0,14)};pw2=(u32x4){PKW(c1,0),PKW(c1,2),PKW(c1,4),PKW(c1,6)};pw3=(u32x4){PKW(c1,8),PKW(c1,10),PKW(c1,12),PKW(c1,14)}; }
  WAIT_BAR(0);
  DMA_K(3,0);DMA_V(2,2*VSLOT);
  sl_prev=sl_cur;sl_cur=sl_next;sl_next=2*SLOTB;
  kload8(kf,kp0+sl_cur);
  WAIT_BAR(3);
  #define VFR(i) (bf16x8){vlo[i][0],vlo[i][1],vlo[i][2],vlo[i][3],vhi[i][0],vhi[i][1],vhi[i][2],vhi[i][3]}
  #define PIN(x) asm volatile("":"+v"(x))
  #define MX3(a,b,c) __builtin_fmaxf(__builtin_fmaxf((a),(b)),(c))
  #define MFM(a,b,c) __builtin_amdgcn_mfma_f32_32x32x16_bf16(a,b,c,0,0,0)
  #define GAPA(MF) do{ MF; SBAR(); }while(0)
  #define EX(v) __builtin_amdgcn_exp2f(v)
  #define GAPB(MF,X,B) do{ MF; X[B]=EX(X[B]); X[B+1]=EX(X[B+1]); X[B+2]=EX(X[B+2]); X[B+3]=EX(X[B+3]); PIN(X); SBAR(); }while(0)
  #define GAPS(MF,A0,A1,A2,A3) do{ MF; sacc+=A0; sacc+=A1; sacc+=A2; sacc+=A3; PIN(sacc); SBAR(); }while(0)
  #define GAPC(MF,A0,A1,A2,A3,W0,W1,PW) do{ MF; sacc+=A0; sacc+=A1; sacc+=A2; sacc+=A3; PIN(sacc); W0; W1; PIN(PW); SBAR(); }while(0)
  #define VRD(i) do{ vlo[i]=vtr(vp_+(((i)>>2)*4096+((i)&3)*1024)); vhi[i]=vtr(vp_+(((i)>>2)*4096+((i)&3)*1024+512)); }while(0)
  #define VRD2(i) do{ vlo[i]=vtr(vp_+(8192+((i)>>2)*4096+((i)&3)*1024)); vhi[i]=vtr(vp_+(8192+((i)>>2)*4096+((i)&3)*1024+512)); }while(0)
  #define KRD(G,j) do{ if(G){ kload2(kf,kp0+sl_next,j); SBAR(); } }while(0)
  #define STEP2(t,GK,GV,GL) do{ SBAR(); \
    const lds_cptr vp_=vp0+vs_prev; \
    VRD(0); SBAR(); GAPA(c0=MFM(kf[0],qr[0],negm)); \
    VRD(4); SBAR(); GAPA(c1=MFM(kf[1],qr[0],negm)); \
    VRD(1); SBAR(); GAPA(c0=MFM(kf[2],qr[1],c0)); \
    VRD(5); SBAR(); GAPA(c1=MFM(kf[3],qr[1],c1)); \
    VRD(2); SBAR(); GAPA(c0=MFM(kf[4],qr[2],c0)); \
    VRD(6); SBAR(); GAPA(c1=MFM(kf[5],qr[2],c1)); \
    VRD(3); SBAR(); GAPA(c0=MFM(kf[6],qr[3],c0)); \
    VRD(7); SBAR(); GAPA(c1=MFM(kf[7],qr[3],c1)); \
    if(GK){DMA_K((t)+3,sl_cur);} if(GV){DMA_V((t)+2,vs_dma);} \
    CMASK(c0,c1,t); CBIAS(c0,c1,t); \
    { float a=MX3(c0[0],c0[1],c1[0]),b=MX3(c0[2],c0[3],c1[1]); a=MX3(a,c1[2],c1[3]); \
      _Pragma("unroll") for(int r=4;r<16;r+=4){a=MX3(a,c0[r],c0[r+1]);b=MX3(b,c0[r+2],c0[r+3]);a=MX3(a,c1[r],c1[r+1]);b=MX3(b,c1[r+2],c1[r+3]);} \
      float rm=__builtin_fmaxf(a,b); { auto rr=__builtin_amdgcn_permlane32_swap(__float_as_uint(rm),__float_as_uint(rm),false,false); rm=__builtin_fmaxf(__uint_as_float(rr[0]),__uint_as_float(rr[1])); } \
      resc=false; \
      if(__builtin_expect(__any(rm>(float)THRL),0)){ const float dl=__builtin_fmaxf(rm,0.f); mhat+=dl; { const float nm_=-mhat; _Pragma("unroll") for(int r=0;r<16;++r)negm[r]=nm_; } \
        _Pragma("unroll") for(int r=0;r<16;++r){c0[r]-=dl;c1[r]-=dl;} \
        const float f=__builtin_amdgcn_exp2f(-dl); l_reg*=f; if(hi==0)wsf[r32]=f; resc=true; } } \
    SBAR(); \
    GAPB(o[0]=MFM(PAF(0),VFR(0),o[0]), c0,0); \
    VRD2(0); SBAR(); GAPB(o[1]=MFM(PAF(0),VFR(4),o[1]), c0,4); \
    VRD2(4); SBAR(); GAPB(o[0]=MFM(PAF(1),VFR(1),o[0]), c0,8); \
    VRD2(1); SBAR(); GAPB(o[1]=MFM(PAF(1),VFR(5),o[1]), c0,12); \
    VRD2(5); SBAR(); GAPB(o[0]=MFM(PAF(2),VFR(2),o[0]), c1,0); \
    VRD2(2); SBAR(); GAPB(o[1]=MFM(PAF(2),VFR(6),o[1]), c1,4); \
    VRD2(6); SBAR(); GAPB(o[0]=MFM(PAF(3),VFR(3),o[0]), c1,8); \
    VRD2(3); SBAR(); GAPB(o[1]=MFM(PAF(3),VFR(7),o[1]), c1,12); \
    float sacc=(c0[0]+c0[1]); \
    VRD2(7); SBAR(); GAPS(o[2]=MFM(PAF(0),VFR(0),o[2]), c0[2],c0[3],c0[4],c0[5]); \
    KRD(GL,0); GAPS(o[3]=MFM(PAF(0),VFR(4),o[3]), c0[6],c0[7],c0[8],c0[9]); \
    KRD(GL,1); GAPC(o[2]=MFM(PAF(1),VFR(1),o[2]), c0[10],c0[11],c0[12],c0[13], pw0[0]=PKW(c0,0), pw0[1]=PKW(c0,2), pw0); \
    KRD(GL,2); GAPC(o[3]=MFM(PAF(1),VFR(5),o[3]), c0[14],c0[15],c1[0],c1[1],   pw0[2]=PKW(c0,4), pw0[3]=PKW(c0,6), pw0); \
    KRD(GL,3); GAPC(o[2]=MFM(PAF(2),VFR(2),o[2]), c1[2],c1[3],c1[4],c1[5],     pw1[0]=PKW(c0,8), pw1[1]=PKW(c0,10), pw1); \
    GAPC(o[3]=MFM(PAF(2),VFR(6),o[3]), c1[6],c1[7],c1[8],c1[9],     pw1[2]=PKW(c0,12),pw1[3]=PKW(c0,14), pw1); \
    GAPC(o[2]=MFM(PAF(3),VFR(3),o[2]), c1[10],c1[11],c1[12],c1[13], pw2[0]=PKW(c1,0), pw2[1]=PKW(c1,2), pw2); \
    GAPC(o[3]=MFM(PAF(3),VFR(7),o[3]), c1[14],c1[15],0.f,0.f,       pw2[2]=PKW(c1,4), pw2[3]=PKW(c1,6), pw2); \
    pw3[0]=PKW(c1,8); pw3[1]=PKW(c1,10); pw3[2]=PKW(c1,12); pw3[3]=PKW(c1,14); PIN(pw3); \
    l_reg+=sacc; \
    }while(0)
  int t=1;
  #undef CMASK
  #undef CBIAS
  #define CMASK(P0,P1,t) do{}while(0)
  #define CBIAS(P0,P1,t) do{}while(0)
  for(;t+7<NT;t+=2){
    STEP2(t,true,true,true);     WAIT_BAR(3); RESC(); ROT();
    STEP2(t+1,true,true,true);   WAIT_BAR(3); RESC(); ROT();
  }
  #undef CMASK
  #undef CBIAS
  #define CMASK(P0,P1,t) do{int jb_=(t)-(NT-4); if(jb_>=0)cmask(P0,P1,jb_,qrel,hi);}while(0)
  #define CBIAS(P0,P1,t) CBIAS_ON(P0,P1,t)
  #define ENDW(tt) do{ if((tt)+3<NT){WAIT_BAR(3);} else if((tt)+2<NT){WAIT_BAR(2);} else {WAIT_BAR(0);} }while(0)
  for(;t+1<NT;t+=2){
    STEP2(t,(t+3<NT),(t+2<NT),(t+1<NT));       ENDW(t);   RESC(); ROT();
    STEP2(t+1,(t+4<NT),(t+3<NT),(t+2<NT));     ENDW(t+1); RESC(); ROT();
  }
  STEP2(NT-1,false,false,false); RESC();
  { const int vlast=(vs_prev+VSLOT)&(NSLOTV*VSLOT-1);
    SBAR(); pv(o,vb0+vlast,PAF(0),PAF(1),PAF(2),PAF(3)); pv(o+2,vb0+vlast+8192,PAF(0),PAF(1),PAF(2),PAF(3)); }
  #undef PKW
  #undef PAF
  #undef VFR
  #undef PIN
  #undef MX3
  #undef MFM
  #undef GAPA
  #undef GAPB
  #undef GAPC
  #undef GAPS
  #undef EX
  #undef VRD
  #undef VRD2
  #undef KRD
  #undef STEP2
  #undef ENDW
  {auto rr=__builtin_amdgcn_permlane32_swap(__float_as_uint(l_reg),__float_as_uint(l_reg),false,false);l_reg=__uint_as_float(rr[0])+__uint_as_float(rr[1]);}
  if(hi==0)wsf[32+r32]=l_reg;asm volatile("s_waitcnt lgkmcnt(0)":::"memory");
  float rli[16];
  #pragma unroll
  for(int r=0;r<16;++r)rli[r]=__builtin_amdgcn_rcpf(wsf[32+crow(r,hi)]);
  bf16*Ow=O+(rowbase+q0+wid*QBLK)*PO;
  { bf16*stg=(bf16*)(shm+L2_OST)+wid*2048;
    #pragma unroll
    for(int ph=0;ph<2;++ph){
      #pragma unroll
      for(int r=0;r<16;++r){const int orow=crow(r,hi);
        #pragma unroll
        for(int d0=0;d0<2;++d0)stg[orow*64+d0*32+r32]=__float2bfloat16(o[2*ph+d0][r]*rli[r]);}
      asm volatile("s_waitcnt lgkmcnt(0)":::"memory");
      #pragma unroll
      for(int i=0;i<4;++i){const int row=i*8+(lane>>3),ch=lane&7; const u32x4 v=*(const u32x4*)(stg+row*64+ch*8); ATTN_STORE16(Ow+(long)row*PO+ph*64+ch*8,v);}
      asm volatile("s_waitcnt lgkmcnt(0)":::"memory"); } }
  asm volatile("s_waitcnt lgkmcnt(0)\n\ts_barrier":::"memory");
  #undef DMA_K
  #undef DMA_V
  #undef CMASK
  #undef CBIAS
  #undef CBIAS_ON
  #undef START
  #undef RESC
  #undef ROT
}
constexpr int ATTN_LDS_BYTES=LDS_BYTES;
#undef SBAR
#undef WAIT_BAR
}


__device__ __forceinline__ void diff_combine(bf16* P, const bf16* OS, int b, int h, int qb, float lam, const float* subg, float omli) {
    const int tid = opaque_tid(); const int row = tid >> 1, vh = tid & 1;
    asm volatile("s_waitcnt vmcnt(0)" ::: "memory"); __syncthreads();
    const size_t grow = (size_t)b * SEQ + (size_t)qb * 256 + row;
    const GAS unsigned long long* o0 = (const GAS unsigned long long*)(OS + grow * 1024 + h * 256 + vh * 64);
    const GAS unsigned long long* o1 = (const GAS unsigned long long*)(OS + grow * 1024 + h * 256 + (2 + vh) * 64);
    float y[64]; float ss = 0.f;
#pragma unroll
    for (int i = 0; i < 16; ++i) { const unsigned long long a = __hip_atomic_load(o0 + i, __ATOMIC_RELAXED, __HIP_MEMORY_SCOPE_AGENT), c = __hip_atomic_load(o1 + i, __ATOMIC_RELAXED, __HIP_MEMORY_SCOPE_AGENT);
        const unsigned a0 = (unsigned)a, a1 = (unsigned)(a >> 32), c0 = (unsigned)c, c1 = (unsigned)(c >> 32);
        y[4 * i] = bflo(a0) - lam * bflo(c0); y[4 * i + 1] = bfhi(a0) - lam * bfhi(c0); y[4 * i + 2] = bflo(a1) - lam * bflo(c1); y[4 * i + 3] = bfhi(a1) - lam * bfhi(c1);
        ss += (y[4 * i] * y[4 * i] + y[4 * i + 1] * y[4 * i + 1]) + (y[4 * i + 2] * y[4 * i + 2] + y[4 * i + 3] * y[4 * i + 3]); }
    ss += shx(ss, tid & 63, 1);
    const float rs = (1.0f / sqrtf(ss * (1.f / 128.f) + LN_EPS)) * omli;
    bf16* yp = P + grow * PP + PC_Q + h * 128 + vh * 64; const float* gp = subg + vh * 64;
#pragma unroll
    for (int i = 0; i < 8; ++i) { u32x4 w;
        w.x = pk2(y[8 * i] * rs * gp[8 * i], y[8 * i + 1] * rs * gp[8 * i + 1]); w.y = pk2(y[8 * i + 2] * rs * gp[8 * i + 2], y[8 * i + 3] * rs * gp[8 * i + 3]);
        w.z = pk2(y[8 * i + 4] * rs * gp[8 * i + 4], y[8 * i + 5] * rs * gp[8 * i + 5]); w.w = pk2(y[8 * i + 6] * rs * gp[8 * i + 6], y[8 * i + 7] * rs * gp[8 * i + 7]);
        *(u32x4*)(yp + 8 * i) = w; }
}

template <int MODE>
__device__ __forceinline__ void ln_phase(const Args& a, LAS unsigned char* lds, float* outf, const float* gam, const float* bet, const float* rw) {
    const int tid = opaque_tid(), lane = tid & 63, wave = tid >> 6;
    unsigned char* ws = a.ws;
    bf16* xb = (bf16*)(ws + WS_XB);
    int* tok_e = (int*)(ws + WS_ROUTE); int* tok_off = tok_e + 2 * M; float* tok_g = (float*)(tok_off + 2 * M);
    const bf16* fs = (const bf16*)(ws + WS_ASORT);
    gu32* cur = (gu32*)(ws + WS_CTL) + CW_CUR;
    LAS int* lcnt = (LAS int*)lds;
    LAS int* lbase = lcnt + 8;
    LAS int* lrow = lcnt + 16;
    if (MODE == 1) { if (tid < 16) lcnt[tid] = 0; __syncthreads(); }
    f32x4 gv[4], bv[4];
#pragma unroll
    for (int q = 0; q < 4; ++q) { gv[q] = *(const f32x4*)(gam + 8 * lane + 512 * (q >> 1) + 4 * (q & 1)); bv[q] = *(const f32x4*)(bet + 8 * lane + 512 * (q >> 1) + 4 * (q & 1)); }
    LAS f32x4* rwlA = (LAS f32x4*)(lds + 4096);
    LAS f32x4* rwlB = rwlA + 1024;

    f32x4 rwr[16][2];
    if (MODE == 1) {
#pragma unroll
        for (int q = 0; q < 4; ++q)
#pragma unroll
            for (int i = 0; i < 4; ++i) { const int col = 8 * lane + 512 * (q >> 1) + 4 * (q & 1) + i; rwr[q * 4 + i][0] = *((const f32x4*)rw + 2 * col); rwr[q * 4 + i][1] = *((const f32x4*)rw + 2 * col + 1); } }
    const int row0 = pair_row0(opaque_s((int)blockIdx.x)); const int rowbase = row0 + wave * 16;
    u32x4 nz[4][2], nw1[4][2], nw2[4][2]; float ng1[4], ng2[4];
    int mypos = 0; float myg = 0.f;
    if (MODE == 2) {
        const int ee = tok_e[2 * rowbase + (lane & 31)], oo = tok_off[2 * rowbase + (lane & 31)]; myg = tok_g[2 * rowbase + (lane & 31)];
        int acc = 0, sb = 0;
#pragma unroll
        for (int e = 0; e < 8; ++e) { sb = (ee == e) ? acc : sb; acc += ((int)__hip_atomic_load(cur + 64 * e, __ATOMIC_RELAXED, __HIP_MEMORY_SCOPE_AGENT) + 255) & ~255; }
        mypos = sb + oo; }
#define LN_LOAD(SL, RR) do { const int rr_ = (RR); const int row_ = rowbase + rr_; const u32x4* zr_ = (const u32x4*)(xb + (size_t)row_ * DM) + lane; \
        if (MODE == 2) { nz[SL][0] = __builtin_nontemporal_load(zr_); nz[SL][1] = __builtin_nontemporal_load(zr_ + 64); } else { nz[SL][0] = zr_[0]; nz[SL][1] = zr_[64]; }     \
        if (MODE == 2) { const int p1 = __builtin_amdgcn_readlane(mypos, 2 * rr_), p2 = __builtin_amdgcn_readlane(mypos, 2 * rr_ + 1); \
            ng1[SL] = __builtin_bit_cast(float, __builtin_amdgcn_readlane(__builtin_bit_cast(int, myg), 2 * rr_)); ng2[SL] = __builtin_bit_cast(float, __builtin_amdgcn_readlane(__builtin_bit_cast(int, myg), 2 * rr_ + 1)); \
            const u32x4* f1 = (const u32x4*)(fs + (size_t)p1 * DM) + lane; const u32x4* f2 = (const u32x4*)(fs + (size_t)p2 * DM) + lane; \
            nw1[SL][0] = __builtin_nontemporal_load(f1); nw1[SL][1] = __builtin_nontemporal_load(f1 + 64); nw2[SL][0] = __builtin_nontemporal_load(f2); nw2[SL][1] = __builtin_nontemporal_load(f2 + 64); } } while (0)
#define LN_UNPK_LO(W_) ((f32x4){bflo((W_).x), bfhi((W_).x), bflo((W_).y), bfhi((W_).y)})
#define LN_UNPK_HI(W_) ((f32x4){bflo((W_).z), bfhi((W_).z), bflo((W_).w), bfhi((W_).w)})
    LN_LOAD(0, 0); LN_LOAD(1, 1); LN_LOAD(2, 2);
#pragma unroll 1
    for (int rq = 0; rq < 16; rq += 4) {
#pragma unroll
      for (int u = 0; u < 4; ++u) {
        const int rr = rq + u;
        const int row = rowbase + rr;
        if (rr + 3 < 16) LN_LOAD((u + 3) & 3, rr + 3);
        f32x4 v[4]; float s = 0.f;
#pragma unroll
        for (int j = 0; j < 2; ++j) { v[2 * j] = LN_UNPK_LO(nz[u][j]); v[2 * j + 1] = LN_UNPK_HI(nz[u][j]); }
        if (MODE == 2) {
#pragma unroll
            for (int j = 0; j < 2; ++j) { const u32x4 w1 = nw1[u][j], w2 = nw2[u][j];
                v[2 * j] = v[2 * j] * ALPHA + LN_UNPK_LO(w1) * ng1[u] + LN_UNPK_LO(w2) * ng2[u];
                v[2 * j + 1] = v[2 * j + 1] * ALPHA + LN_UNPK_HI(w1) * ng1[u] + LN_UNPK_HI(w2) * ng2[u]; }
        }
#pragma unroll
        for (int j = 0; j < 4; ++j) s += (v[j].x + v[j].y) + (v[j].z + v[j].w);
        const float mean = wave_sum(s, lane) * (1.f / DM); float s2 = 0.f;
#pragma unroll
        for (int j = 0; j < 4; ++j) { v[j] = v[j] - mean; s2 += (v[j].x * v[j].x + v[j].y * v[j].y) + (v[j].z * v[j].z + v[j].w * v[j].w); }
        const float rstd = 1.f / sqrtf(wave_sum(s2, lane) * (1.f / DM) + LN_EPS);
#pragma unroll
        for (int j = 0; j < 4; ++j) v[j] = v[j] * rstd * gv[j] + bv[j];
        if (MODE != 2) { u32x4* o = (u32x4*)(xb + (size_t)row * DM) + lane; o[0] = pack8(v[0], v[1]); o[64] = pack8(v[2], v[3]); }
        else { f32x4* of = (f32x4*)(outf + (size_t)row * DM + 8 * lane); __builtin_nontemporal_store(v[0], of); __builtin_nontemporal_store(v[1], of + 1); __builtin_nontemporal_store(v[2], of + 128); __builtin_nontemporal_store(v[3], of + 129); }
        if (MODE == 1) {
            float lg[8];
#pragma unroll
            for (int e = 0; e < 8; ++e) lg[e] = 0.f;
#pragma unroll
            for (int q = 0; q < 4; ++q)
#pragma unroll
                for (int i = 0; i < 4; ++i) { const float xv = v[q][i]; const f32x4 r0 = rwr[q * 4 + i][0], r1 = rwr[q * 4 + i][1];
                    lg[0] += xv * r0.x; lg[1] += xv * r0.y; lg[2] += xv * r0.z; lg[3] += xv * r0.w;
                    lg[4] += xv * r1.x; lg[5] += xv * r1.y; lg[6] += xv * r1.z; lg[7] += xv * r1.w; }
#pragma unroll
            for (int e = 0; e < 8; ++e) lg[e] = wave_sum(lg[e], lane);
            int i1 = 0; float v1 = lg[0];
#pragma unroll
            for (int e = 1; e < 8; ++e) if (lg[e] > v1) { v1 = lg[e]; i1 = e; }
            int i2 = -1; float v2 = -INFINITY;
#pragma unroll
            for (int e = 0; e < 8; ++e) if (e != i1 && lg[e] > v2) { v2 = lg[e]; i2 = e; }
            const float ex = __expf(v2 - v1); const float w1 = 1.0f / (1.0f + ex), w2 = ex * w1;
            if (lane == 0) {
                const int k1 = atomicAdd((int*)&lcnt[i1], 1), k2 = atomicAdd((int*)&lcnt[i2], 1);
                lrow[(wave * 16 + rr) * 4 + 0] = i1; lrow[(wave * 16 + rr) * 4 + 1] = i2; lrow[(wave * 16 + rr) * 4 + 2] = k1; lrow[(wave * 16 + rr) * 4 + 3] = k2;
                tok_g[2 * row] = w1; tok_g[2 * row + 1] = w2;
            }
        }
      }
    }
    if (MODE == 1) { asm volatile("s_waitcnt vmcnt(0)" ::: "memory");
#pragma unroll 4
        for (int rr = 0; rr < 16; ++rr) { const int row = rowbase + rr; const u32x4* src = (const u32x4*)(xb + (size_t)row * DM) + lane; u32x2* o8 = (u32x2*)(ws + WS_XB8 + (size_t)row * DM) + lane;
#pragma unroll
            for (int j = 0; j < 2; ++j) { const u32x4 w = src[64 * j];
                o8[64 * j] = (u32x2){pk4f8(bflo(w.x) * F8_SC_Y, bfhi(w.x) * F8_SC_Y, bflo(w.y) * F8_SC_Y, bfhi(w.y) * F8_SC_Y), pk4f8(bflo(w.z) * F8_SC_Y, bfhi(w.z) * F8_SC_Y, bflo(w.w) * F8_SC_Y, bfhi(w.w) * F8_SC_Y)}; } } }
#undef LN_LOAD
#undef LN_UNPK_LO
#undef LN_UNPK_HI
    if (MODE == 1) {
        __syncthreads();
        if (tid < 8) lbase[tid] = (int)__hip_atomic_fetch_add(cur + 64 * tid, (unsigned)lcnt[tid], __ATOMIC_RELAXED, __HIP_MEMORY_SCOPE_AGENT);
        __syncthreads();
        if (tid < 128) { const int row = row0 + tid; const int e1 = lrow[tid * 4], e2 = lrow[tid * 4 + 1];
            const int o1 = lbase[e1] + lrow[tid * 4 + 2], o2 = lbase[e2] + lrow[tid * 4 + 3];
            tok_e[2 * row] = e1; tok_e[2 * row + 1] = e2; tok_off[2 * row] = o1; tok_off[2 * row + 1] = o2;
            int* rowtok = (int*)(ws + WS_ROWTOK); rowtok[e1 * 32768 + o1] = row; rowtok[e2 * 32768 + o2] = row; }
        __syncthreads();
    }
}

template <int l> __device__ __forceinline__ void layer_body(const Args& args, LAS unsigned char* lds, unsigned char* lds_raw, const XcdBarrier& bar) {
#define GRID_BAR() xcd_barrier(bar)
        {   unsigned char* ws = opq(args.ws); const int blk = opaque_s((int)blockIdx.x), G = opaque_s((int)gridDim.x);
            Gemm g{(const bf16*)(ws + WS_XB), (const bf16*)(ws + WS_WIN) + (size_t)l * DIN * DM, DM, DM};
            EpiInProj E{(bf16*)(ws + WS_P)};
            if (l == 0) { StaticOrder S; S.init(M, DIN, G, blk); GEMM_PHASE(lds, g, S, E); }
            else {
                pair_sync((unsigned*)((gu32*)(ws + WS_CTL) + CW_PAIR) + 16 * (3 * 128 + 2 * 64 + quad_id(blk)), bar, 4u);
                QuadOrder S; S.c = blk; S.nn = DIN / 256; GEMM_PHASE(lds, g, S, E); }
        }
        GRID_BAR();
        {
            unsigned char* ws = opq(args.ws); const int blk = opaque_s((int)blockIdx.x), G = opaque_s((int)gridDim.x);
            bf16* P = (bf16*)(ws + WS_P);
            const float lam_init = (l == 0) ? 0.2f : (0.8f - 0.6f * 0.7408182206817179f);
            float lam;
            LAS float* btab = (LAS float*)(lds + RING_BYTES - 2048);
            LAS float* xtab = (LAS float*)(lds + RING_BYTES - 6144);
            {   const int tid = opaque_tid(), lane = tid & 63;
                const float* q1 = args.in[I_LQ1] + l * 64; const float* k1 = args.in[I_LK1] + l * 64; const float* q2 = args.in[I_LQ2] + l * 64; const float* k2 = args.in[I_LK2] + l * 64;
                const float d1 = wave_sum(q1[lane] * k1[lane], lane), d2 = wave_sum(q2[lane] * k2[lane], lane);
                lam = __builtin_bit_cast(float, __builtin_amdgcn_readfirstlane(__builtin_bit_cast(int, __expf(d1) - __expf(d2) + lam_init)));
                __syncthreads();
                const int hh = tid >> 7, d = tid & 127; const float* rb = args.in[I_RELB];
                btab[hh * 128 + d] = (rb[t5_bucket(d) * 4 + hh] - rb[31 * 4 + hh]) * LOG2E;
                __syncthreads();
                {   const int vcu_ = (blk & 7) * (G >> 3) + (blk >> 3); const int h_ = (vcu_ >> 5) & 3;
                    for (int i = tid; i < 640; i += NTHR) { const int dist = i - 256; xtab[i] = (dist >= 0 && dist < 128) ? btab[h_ * 128 + dist] : 0.f; } }
                __syncthreads(); }
#ifdef USE_NAIVE_ATTN
            for (int i = 0; i < 8; ++i) {
                const int L = i * G + blk; const int bh = L & 7, qt = L >> 3;
                nattn_unit(lds, P, bh >> 2, bh & 3, qt, btab + (bh & 3) * 128, lam, args.in[I_SUBG] + l * 128, 1.0f - lam_init);
            }
#else
            {
                const int vcu = (blk & 7) * (G >> 3) + (blk >> 3); const int bh = vcu >> 5, sp = vcu & 31, b = bh >> 2, h = bh & 3;
                bf16* OS = (bf16*)(ws + WS_OSCR);
#pragma unroll 1
                for (int u4 = 0; u4 < 4; ++u4) {
                    const int m = u4 >> 1; const int qb = (u4 & 1) ? sp : 63 - sp;
                    attn_body::attn_unit2<8>(b, qb, (const attn_body::bf16*)(P + PC_Q + h * 128 + m * 64), (const attn_body::bf16*)(P + PC_K + h * 128 + m * 64),
                                             (const attn_body::bf16*)(P + PC_VA + h * 128), (attn_body::bf16*)(OS + h * 256 + m * 128), xtab, (char*)lds_raw);
                    if (u4 >= 2) diff_combine(P, OS, b, h, qb, lam, args.in[I_SUBG] + l * 128, 1.0f - lam_init);
                }
                __syncthreads();
            }
#endif
            chunk_unit(lds, P, blk, (const bf16*)(ws + WS_WB) + (size_t)l * 4 * 128 * 128, args.in[I_GBS] + l * 512, (const bf16*)(ws + WS_PWT) + (size_t)l * 4 * 64 * 64, args.in[I_POOLS] + l * 256);
        }
        GRID_BAR();
        {   unsigned char* ws = opq(args.ws); const int blk = opaque_s((int)blockIdx.x), G = opaque_s((int)gridDim.x);
            Gemm g{(const bf16*)(ws + WS_P), (const bf16*)(ws + WS_WOUT) + (size_t)l * DM * DM, PP, DM};
            PairOrder S; S.c = blk;
            EpiResid E{(bf16*)(ws + WS_XB)};
            GEMM_PHASE(lds, g, S, E);
            pair_sync((unsigned*)((gu32*)(ws + WS_CTL) + CW_PAIR) + 16 * ((l * 2) * 128 + pair_panel(blk)), bar);
        }
        if (l == 0) ln_phase<0>(args, lds, opq(args.out), args.in[I_LN1G] + l * DM, args.in[I_LN1B] + l * DM, nullptr);
        else ln_phase<1>(args, lds, opq(args.out), args.in[I_LN1G] + l * DM, args.in[I_LN1B] + l * DM, args.in[I_RW]);
        if (l == 0) {
            {   unsigned char* ws = opq(args.ws); const int blk = opaque_s((int)blockIdx.x);
                unsigned* qw = (unsigned*)((gu32*)(ws + WS_CTL) + CW_PAIR) + 16 * (3 * 128 + quad_id(blk));
                pair_sync(qw, bar, 4u);
                Gemm g{(const bf16*)(ws + WS_XB), (const bf16*)(ws + WS_W13), DM, DM};
                QuadOrder S; S.c = blk; S.nn = 22;
                EpiSwiglu8 E{(unsigned char*)(ws + WS_HID), DFF};
                GEMM_PHASE(lds, g, S, E);
                pair_sync(qw + 16 * 64, bar, 4u);
            }
            {   unsigned char* ws = opq(args.ws); const int blk = opaque_s((int)blockIdx.x), G = opaque_s((int)gridDim.x);
                Gemm g{(const bf16*)(ws + WS_HID), (const bf16*)(ws + WS_W2), DFF, DFF, F8_E8_H, F8_E8_W};
                PairOrder S; S.c = blk;
                EpiResid E{(bf16*)(ws + WS_XB)};
                pg8::gemm_phase<EpiResid, PairOrder, false, false, true>(lds, g, S, E);
                pair_sync((unsigned*)((gu32*)(ws + WS_CTL) + CW_PAIR) + 16 * (1 * 128 + pair_panel(blk)), bar);
            }
            ln_phase<0>(args, lds, opq(args.out), args.in[I_LN2G] + l * DM, args.in[I_LN2B] + l * DM, nullptr);
        } else {
            GRID_BAR();
            unsigned char* ws = opq(args.ws); const int blk = opaque_s((int)blockIdx.x), G = opaque_s((int)gridDim.x);
            gu32* ctl = (gu32*)(ws + WS_CTL);
            bf16* asort = (bf16*)(ws + WS_ASORT); const bf16* xb = (const bf16*)(ws + WS_XB);
            int seg[9]; seg[0] = 0;
#pragma unroll
            for (int e = 0; e < 8; ++e) { const int cnt = __builtin_amdgcn_readfirstlane((int)__hip_atomic_load(ctl + CW_CUR + 64 * e, __ATOMIC_RELAXED, __HIP_MEMORY_SCOPE_AGENT)); seg[e + 1] = seg[e] + ((cnt + 255) & ~255); }
            const int ntot = seg[8] >> 8;
            MoeOrder S; S.ts1 = seg[1] >> 8; S.ts2 = seg[2] >> 8; S.ts3 = seg[3] >> 8; S.ts4 = seg[4] >> 8; S.ts5 = seg[5] >> 8; S.ts6 = seg[6] >> 8; S.ts7 = seg[7] >> 8; S.G = G; S.c = blk; S.rowtok = (const int*)(ws + WS_ROWTOK);
            const int nf = ntot >> 7, nr = ntot & 127, ns = nf + (nr > 0 ? 1 : 0);
            bf16* hbuf0 = (bf16*)opq(args.out); bf16* hbuf1 = (bf16*)(ws + WS_HCH);
            for (int j = 0; j <= ns; ++j) {
                if (j >= 1) {
                    const int jj = j - 1; const bool rem = (nr > 0 && jj == 0); const int k = jj - (nr > 0 ? 1 : 0);
                    S.c0 = rem ? nf * 128 : k * 128; S.ntc = rem ? nr : 128; S.ncol = 4; S.up = false; S.skipn = 0;
                    Gemm g{(jj & 1) ? hbuf1 : hbuf0, (const bf16*)(ws + WS_MW2), DFE, DFE, F8_E8_H, F8_E8_W};
                    EpiPlain E{asort, DM};
                    pg8::gemm_phase<EpiPlain, MoeOrder, false, false, true>(lds, g, S, E);
                }
                if (j < ns) {
                    const bool rem = (nr > 0 && j == 0); const int k = j - (nr > 0 ? 1 : 0);
                    const int ndown = (j >= 1) ? S.ntc * 4 : 0;
                    S.c0 = rem ? nf * 128 : k * 128; S.ntc = rem ? nr : 128; S.ncol = 28; S.up = true; S.skipn = (ndown > 0 && ndown < G) ? ndown : 0;
                    Gemm g{(const bf16*)(ws + WS_XB8), (const bf16*)(ws + WS_MW13), DM, DM, F8_E8_Y, F8_E8_W};
                    EpiSwiglu8 E{(unsigned char*)((j & 1) ? hbuf1 : hbuf0), DFE};
                    pg8::gemm_phase<EpiSwiglu8, MoeOrder, true, false, true>(lds, g, S, E);
                }
                GRID_BAR();
            }
            ln_phase<2>(args, lds, opq(args.out), args.in[I_LN2G] + l * DM, args.in[I_LN2B] + l * DM, nullptr);
        }
#undef GRID_BAR
}

__global__ void __launch_bounds__(NTHR, 2) fwd_kernel(Args args) {
    extern __shared__ __attribute__((aligned(16))) unsigned char lds_raw[];
    LAS unsigned char* lds = (LAS unsigned char*)lds_raw;
    {   const int tid = threadIdx.x;
        for (int u = tid; u < (LDS_BYTES - LDSCTL_OFF) / 4; u += NTHR) ((LAS unsigned*)(lds + LDSCTL_OFF))[u] = 0u;
        __syncthreads(); }
    XcdBarrier bar = xcd_barrier_post((unsigned*)((gu32*)(args.ws + WS_CTL) + CW_BAR), (volatile LAS unsigned*)(lds + MISC_OFF) + 8);
#define GRID_BAR() xcd_barrier(bar)

    {   const int tid = opaque_tid(), lane = tid & 63, wave = __builtin_amdgcn_readfirstlane(tid >> 6);
        prologue(args, lds, (int)blockIdx.x * NWAVES + wave, (int)gridDim.x * NWAVES, wave, lane); }
    {   const int blk = opaque_s((int)blockIdx.x); unsigned* xw = bar.bar + opaque0() - CW_BAR + CW_XCC + blk;
        if (opaque_tid() == 0) (void)xb_add(xw, bar.x + 1u); }
    GRID_BAR();

    layer_body<0>(args, lds, lds_raw, bar);
    layer_body<1>(args, lds, lds_raw, bar);
#undef GRID_BAR
}

extern "C" void kernel_launch(void* const* d_in, const int* in_sizes, int n_in, void* d_out, int out_size, void* d_ws, size_t ws_size, hipStream_t stream) {
    static int ready = 0;
    if (ready == 0) {
        if (n_in != 24 || in_sizes[0] != M * DM || out_size != M * DM || ws_size < WS_END) { fprintf(stderr, "kernel_launch: unexpected shapes (n_in %d, in0 %d, out %d, ws %zu)\n", n_in, n_in > 0 ? in_sizes[0] : -1, out_size, ws_size); ready = -1; return; }
        if (hipFuncSetAttribute((const void*)fwd_kernel, hipFuncAttributeMaxDynamicSharedMemorySize, LDS_BYTES) != hipSuccess) { fprintf(stderr, "kernel_launch: hipFuncSetAttribute failed\n"); ready = -1; return; }
        int per_cu = 0;
        if (hipOccupancyMaxActiveBlocksPerMultiprocessor(&per_cu, (const void*)fwd_kernel, NTHR, LDS_BYTES) != hipSuccess || per_cu < 1) fprintf(stderr, "kernel_launch: occupancy query says %d\n", per_cu);
        (void)hipGetLastError();
        ready = 1;
    }
    if (ready < 0) return;
    (void)hipMemsetAsync((char*)d_ws + WS_CTL, 0, CTL_ZERO_BYTES, stream);
    Args a{};
    for (int i = 0; i < 24; ++i) a.in[i] = (const float*)d_in[i];
    a.out = (float*)d_out; a.ws = (unsigned char*)d_ws;
    hipLaunchKernelGGL(fwd_kernel, dim3(GRID), dim3(NTHR), LDS_BYTES, stream, a);
}
```
